# Optimizing an MI355X kernel written in HIP

```python
import math
import jax, jax.numpy as jnp
from jax import lax
import numpy as np

D_MODEL = 1024
BATCH = 4
SEQ = 8192
DEPTH = 2

GRID_W = 64
CTX_LEN = 256
EPS = 1e-6
ROPE_BASE = 10000.0
QBLK = 128

GQA_HEADS = 4
GQA_KV_HEADS = 2
GQA_GROUP = GQA_HEADS // GQA_KV_HEADS
GQA_DIM = 64
NA_HEADS = 4
NA_DIM = 64
NA_WIN_ROWS = 8
NA_WIN_COLS = 16
DIFF_HEADS = 4
DIFF_QK_DIM = 32
DIFF_V_DIM = 64
MLA_HEADS = 4
MLA_NOPE = 64
MLA_ROPE = 32
MLA_V = 64
MLA_Q_LORA = 192
MLA_KV_LORA = 128

MIX_WIDTH = GQA_HEADS * GQA_DIM + NA_HEADS * NA_DIM + DIFF_HEADS * DIFF_V_DIM + MLA_HEADS * MLA_V
IN_SPLITS = (
    GQA_HEADS * GQA_DIM, GQA_KV_HEADS * GQA_DIM, GQA_KV_HEADS * GQA_DIM,
    NA_HEADS * NA_DIM, NA_HEADS * NA_DIM, NA_HEADS * NA_DIM,
    DIFF_HEADS * 2 * DIFF_QK_DIM, DIFF_HEADS * 2 * DIFF_QK_DIM, DIFF_HEADS * DIFF_V_DIM,
    MLA_Q_LORA, MLA_KV_LORA, MLA_ROPE,
)
IN_COLS = sum(IN_SPLITS)

N_EXPERTS = 16
MOE_GROUPS = 4
EXPERTS_PER_GROUP = N_EXPERTS // MOE_GROUPS
MOE_TOPK_GROUPS = 1
MOE_TOPK = 2
D_EXPERT = 256
D_SHARED = 256

kernel_name = 'hymba_style_hybrid_dit_block'


def rms_norm(x, g):
    xf = x.astype(jnp.float32)
    y = xf * lax.rsqrt(jnp.mean(xf * xf, axis=-1, keepdims=True) + EPS)
    return (y * g.astype(jnp.float32)).astype(x.dtype)


def modulate(h, shift, scale):
    return h * (1 + scale) + shift


def axial_angles(n_tok, rot_dim):
    half = rot_dim // 2
    freqs = ROPE_BASE ** (-jnp.arange(0, half, 2, dtype=jnp.float32) / half)
    t = jnp.arange(n_tok, dtype=jnp.int32)
    row = (t // GRID_W).astype(jnp.float32)
    col = (t % GRID_W).astype(jnp.float32)
    return row[:, None] * freqs, col[:, None] * freqs


def rope_1d(x, ang):
    shape = (1, ang.shape[0]) + (1,) * (x.ndim - 3) + (ang.shape[1],)
    cos = jnp.cos(ang).reshape(shape).astype(x.dtype)
    sin = jnp.sin(ang).reshape(shape).astype(x.dtype)
    x1, x2 = jnp.split(x, 2, axis=-1)
    return jnp.concatenate([x1 * cos - x2 * sin, x1 * sin + x2 * cos], axis=-1)


def rope_2d(x, ang):
    ang_r, ang_c = ang
    m = x.shape[-1] // 2
    return jnp.concatenate([rope_1d(x[..., :m], ang_r), rope_1d(x[..., m:], ang_c)], axis=-1)


def split_cols(u):
    offsets = [int(o) for o in np.cumsum(IN_SPLITS)[:-1]]
    return jnp.split(u, offsets, axis=-1)


def attend(q, kvs, scale):
    s = jnp.concatenate([jnp.einsum('bqhgd,bkhd->bhgqk', q, k) for k, _ in kvs], axis=-1)
    p = jax.nn.softmax(s.astype(jnp.float32) * scale, axis=-1)
    out = 0
    start = 0
    for k, v in kvs:
        n = k.shape[1]
        out = out + jnp.einsum('bhgqk,bkhd->bqhgd', p[..., start:start + n].astype(v.dtype), v)
        start += n
    return out


def blocked_attend(q, kvs, scale):
    b, s = q.shape[:2]
    nb = s // QBLK
    qb = jnp.moveaxis(q.reshape((b, nb, QBLK) + q.shape[2:]), 1, 0)
    ob = lax.map(lambda qi: attend(qi, kvs, scale), qb)
    return jnp.moveaxis(ob, 0, 1).reshape((b, s) + ob.shape[3:])


def gqa_mixer(q, k, v, qc, kc, vc, q_gain, k_gain, ang, want_ctx):
    scale = GQA_DIM ** -0.5
    def heads(qx, kx, vx, rotate):
        b, n = qx.shape[:2]
        qx = rms_norm(qx.reshape(b, n, GQA_KV_HEADS, GQA_GROUP, GQA_DIM), q_gain)
        kx = rms_norm(kx.reshape(b, n, GQA_KV_HEADS, GQA_DIM), k_gain)
        vx = vx.reshape(b, n, GQA_KV_HEADS, GQA_DIM)
        if rotate:
            qx = rope_2d(qx, ang)
            kx = rope_2d(kx, ang)
        return qx, kx, vx
    ql, kl, vl = heads(q, k, v, True)
    qcx, kcx, vcx = heads(qc, kc, vc, False)
    b, s = q.shape[:2]
    out_lat = blocked_attend(ql, ((kl, vl), (kcx, vcx)), scale).reshape(b, s, GQA_HEADS * GQA_DIM)
    out_ctx = None
    if want_ctx:
        out_ctx = attend(qcx, ((kcx, vcx),), scale).reshape(b, qc.shape[1], GQA_HEADS * GQA_DIM)
    return out_lat, out_ctx


def na_mixer(q, k, v, qc, kc, vc, rel_bias, want_ctx):
    scale = NA_DIM ** -0.5
    b, s = q.shape[:2]
    L = qc.shape[1]
    rows = s // GRID_W
    kh = min(NA_WIN_ROWS, rows)
    kw = NA_WIN_COLS
    n_nb = kh * kw
    qg = q.reshape(b, rows, GRID_W, NA_HEADS, NA_DIM)
    kg = k.reshape(b, rows, GRID_W, NA_HEADS, NA_DIM)
    vg = v.reshape(b, rows, GRID_W, NA_HEADS, NA_DIM)
    qcx = qc.reshape(b, L, NA_HEADS, NA_DIM)
    kcx = kc.reshape(b, L, NA_HEADS, NA_DIM)
    vcx = vc.reshape(b, L, NA_HEADS, NA_DIM)
    cols = jnp.arange(GRID_W)
    col_idx = jnp.clip(cols - kw // 2, 0, GRID_W - kw)[:, None] + jnp.arange(kw)[None, :]
    dc = col_idx - cols[:, None]

    def row_block(r):
        r0 = jnp.clip(r - kh // 2, 0, rows - kh)
        k_rows = lax.dynamic_slice_in_dim(kg, r0, kh, axis=1)
        v_rows = lax.dynamic_slice_in_dim(vg, r0, kh, axis=1)
        k_nb = jnp.moveaxis(k_rows[:, :, col_idx], 1, 2).reshape(b, GRID_W, n_nb, NA_HEADS, NA_DIM)
        v_nb = jnp.moveaxis(v_rows[:, :, col_idx], 1, 2).reshape(b, GRID_W, n_nb, NA_HEADS, NA_DIM)
        q_row = lax.dynamic_index_in_dim(qg, r, axis=1, keepdims=False)
        dr = r0 + jnp.arange(kh) - r
        bias = rel_bias[:, dr[:, None, None] + (NA_WIN_ROWS - 1), dc[None] + (NA_WIN_COLS - 1)]
        bias = jnp.moveaxis(bias, 1, 2).reshape(NA_HEADS, GRID_W, n_nb)
        s_nb = jnp.einsum('bqhd,bqkhd->bhqk', q_row, k_nb).astype(jnp.float32) * scale + bias.astype(jnp.float32)
        s_c = jnp.einsum('bqhd,bkhd->bhqk', q_row, kcx).astype(jnp.float32) * scale
        p = jax.nn.softmax(jnp.concatenate([s_nb, s_c], axis=-1), axis=-1)
        return (jnp.einsum('bhqk,bqkhd->bqhd', p[..., :n_nb].astype(v.dtype), v_nb)
                + jnp.einsum('bhqk,bkhd->bqhd', p[..., n_nb:].astype(v.dtype), vcx))

    o = lax.map(row_block, jnp.arange(rows))
    out_lat = jnp.moveaxis(o, 0, 1).reshape(b, s, NA_HEADS * NA_DIM)
    out_ctx = None
    if want_ctx:
        out_ctx = attend(qcx[:, :, :, None], ((kcx, vcx),), scale).reshape(b, L, NA_HEADS * NA_DIM)
    return out_lat, out_ctx


def diff_mixer(q, k, v, qc, kc, vc, lq1, lk1, lq2, lk2, subln, lam_init, ang, want_ctx):
    scale = DIFF_QK_DIM ** -0.5
    lam = (jnp.exp(jnp.sum(lq1.astype(jnp.float32) * lk1.astype(jnp.float32)))
           - jnp.exp(jnp.sum(lq2.astype(jnp.float32) * lk2.astype(jnp.float32))) + lam_init).astype(q.dtype)
    def heads(qx, kx, vx, rotate):
        b, n = qx.shape[:2]
        qx = qx.reshape(b, n, DIFF_HEADS * 2, DIFF_QK_DIM)
        kx = kx.reshape(b, n, DIFF_HEADS * 2, DIFF_QK_DIM)
        if rotate:
            qx = rope_2d(qx, ang)
            kx = rope_2d(kx, ang)
        return (qx.reshape(b, n, DIFF_HEADS, 2, DIFF_QK_DIM), kx.reshape(b, n, DIFF_HEADS, 2, DIFF_QK_DIM),
                vx.reshape(b, n, DIFF_HEADS, DIFF_V_DIM))
    def combine(o1, o2):
        o = rms_norm(o1 - lam * o2, subln) * (1.0 - lam_init)
        return o.reshape(o.shape[0], o.shape[1], DIFF_HEADS * DIFF_V_DIM)
    ql, kl, vl = heads(q, k, v, True)
    qcx, kcx, vcx = heads(qc, kc, vc, False)
    o1 = blocked_attend(ql[:, :, :, 0:1], ((kl[:, :, :, 0], vl), (kcx[:, :, :, 0], vcx)), scale)
    o2 = blocked_attend(ql[:, :, :, 1:2], ((kl[:, :, :, 1], vl), (kcx[:, :, :, 1], vcx)), scale)
    out_lat = combine(o1, o2)
    out_ctx = None
    if want_ctx:
        c1 = attend(qcx[:, :, :, 0:1], ((kcx[:, :, :, 0], vcx),), scale)
        c2 = attend(qcx[:, :, :, 1:2], ((kcx[:, :, :, 1], vcx),), scale)
        out_ctx = combine(c1, c2)
    return out_lat, out_ctx


def mla_mixer(cq, ckv, kpe, cqc, ckvc, kpec, q_norm, w_q_up, kv_norm, w_kv_up, ang, want_ctx):
    scale = (MLA_NOPE + MLA_ROPE) ** -0.5
    def heads(cqx, ckvx, kpex, rotate):
        b, n = cqx.shape[:2]
        qx = (rms_norm(cqx, q_norm) @ w_q_up).reshape(b, n, MLA_HEADS, MLA_NOPE + MLA_ROPE)
        kvx = (rms_norm(ckvx, kv_norm) @ w_kv_up).reshape(b, n, MLA_HEADS, MLA_NOPE + MLA_V)
        q_nope, q_pe = qx[..., :MLA_NOPE], qx[..., MLA_NOPE:]
        k_nope, vx = kvx[..., :MLA_NOPE], kvx[..., MLA_NOPE:]
        k_pe = kpex[:, :, None, :]
        if rotate:
            q_pe = rope_2d(q_pe, ang)
            k_pe = rope_2d(k_pe, ang)
        qx = jnp.concatenate([q_nope, q_pe], axis=-1)
        kx = jnp.concatenate([k_nope, jnp.broadcast_to(k_pe, k_nope.shape[:-1] + (MLA_ROPE,))], axis=-1)
        return qx[:, :, :, None], kx, vx
    ql, kl, vl = heads(cq, ckv, kpe, True)
    qcx, kcx, vcx = heads(cqc, ckvc, kpec, False)
    b, s = cq.shape[:2]
    out_lat = blocked_attend(ql, ((kl, vl), (kcx, vcx)), scale).reshape(b, s, MLA_HEADS * MLA_V)
    out_ctx = None
    if want_ctx:
        out_ctx = attend(qcx, ((kcx, vcx),), scale).reshape(b, cqc.shape[1], MLA_HEADS * MLA_V)
    return out_lat, out_ctx


def swiglu(x, wg, wu, wd):
    return (jax.nn.silu(x @ wg) * (x @ wu)) @ wd


def moe_ffn(h, router_w, router_b, w_gate, w_up, w_down, ws_gate, ws_up, ws_down):
    shp = h.shape
    xs = h.reshape(-1, shp[-1])
    scores = jax.nn.sigmoid((xs @ router_w).astype(jnp.float32))
    sel = scores + router_b.astype(jnp.float32)
    grp = sel.reshape(-1, MOE_GROUPS, EXPERTS_PER_GROUP)
    grp_score = lax.top_k(grp, 2)[0].sum(-1)
    _, g_idx = lax.top_k(grp_score, MOE_TOPK_GROUPS)
    g_mask = (g_idx[..., None] == jnp.arange(MOE_GROUPS)).any(axis=1)
    e_mask = jnp.repeat(g_mask, EXPERTS_PER_GROUP, axis=1)
    _, e_idx = lax.top_k(jnp.where(e_mask, sel, -jnp.inf), MOE_TOPK)
    w = jnp.take_along_axis(scores, e_idx, axis=-1)
    w = w / jnp.sum(w, axis=-1, keepdims=True)
    gates = jnp.sum(jax.nn.one_hot(e_idx, N_EXPERTS, dtype=jnp.float32) * w[..., None], axis=1).astype(xs.dtype)
    out = swiglu(xs, ws_gate, ws_up, ws_down)
    for e in range(N_EXPERTS):
        out = out + gates[:, e:e + 1] * swiglu(xs, w_gate[e], w_up[e], w_down[e])
    return out.reshape(shp)


def setup_inputs(seed: int = 0) -> dict:
    key = jax.random.key(seed)
    ks = list(jax.random.split(key, 31))
    def nrm(shape, scale):
        return jax.random.normal(ks.pop(), shape, jnp.float32) * scale
    def gain(shape):
        return 1.0 + nrm(shape, 0.1)
    D = D_MODEL
    return {
        'x': nrm((BATCH, SEQ, D), 1.0),
        'c': nrm((BATCH, D), 1.0),
        'ctx': nrm((BATCH, CTX_LEN, D), 1.0),
        'c_ctx': nrm((D,), 1.0),
        'w_mod': nrm((DEPTH, D, 6 * D), 0.5 * D ** -0.5),
        'b_mod': nrm((DEPTH, 6 * D), 0.01),
        'norm_mix': gain((DEPTH, D)),
        'norm_ffn': gain((DEPTH, D)),
        'w_in': nrm((DEPTH, D, IN_COLS), D ** -0.5),
        'w_out': nrm((DEPTH, MIX_WIDTH, D), MIX_WIDTH ** -0.5),
        'gqa_q_norm': gain((DEPTH, GQA_DIM)),
        'gqa_k_norm': gain((DEPTH, GQA_DIM)),
        'na_rel_bias': nrm((DEPTH, NA_HEADS, 2 * NA_WIN_ROWS - 1, 2 * NA_WIN_COLS - 1), 0.1),
        'diff_lq1': nrm((DEPTH, DIFF_QK_DIM), 0.1),
        'diff_lk1': nrm((DEPTH, DIFF_QK_DIM), 0.1),
        'diff_lq2': nrm((DEPTH, DIFF_QK_DIM), 0.1),
        'diff_lk2': nrm((DEPTH, DIFF_QK_DIM), 0.1),
        'diff_subln': gain((DEPTH, DIFF_V_DIM)),
        'mla_q_norm': gain((DEPTH, MLA_Q_LORA)),
        'mla_w_q_up': nrm((DEPTH, MLA_Q_LORA, MLA_HEADS * (MLA_NOPE + MLA_ROPE)), MLA_Q_LORA ** -0.5),
        'mla_kv_norm': gain((DEPTH, MLA_KV_LORA)),
        'mla_w_kv_up': nrm((DEPTH, MLA_KV_LORA, MLA_HEADS * (MLA_NOPE + MLA_V)), MLA_KV_LORA ** -0.5),
        'router_w': nrm((D, N_EXPERTS), D ** -0.5),
        'router_b': nrm((N_EXPERTS,), 0.01),
        'moe_w_gate': nrm((DEPTH, N_EXPERTS, D, D_EXPERT), D ** -0.5),
        'moe_w_up': nrm((DEPTH, N_EXPERTS, D, D_EXPERT), D ** -0.5),
        'moe_w_down': nrm((DEPTH, N_EXPERTS, D_EXPERT, D), D_EXPERT ** -0.5),
        'shared_w_gate': nrm((DEPTH, D, D_SHARED), D ** -0.5),
        'shared_w_up': nrm((DEPTH, D, D_SHARED), D ** -0.5),
        'shared_w_down': nrm((DEPTH, D_SHARED, D), D_SHARED ** -0.5),
        'final_norm': gain((D,)),
    }


def reference(x, c, ctx, c_ctx, w_mod, b_mod, norm_mix, norm_ffn, w_in, w_out,
              gqa_q_norm, gqa_k_norm, na_rel_bias, diff_lq1, diff_lk1, diff_lq2, diff_lk2, diff_subln,
              mla_q_norm, mla_w_q_up, mla_kv_norm, mla_w_kv_up, router_w, router_b,
              moe_w_gate, moe_w_up, moe_w_down, shared_w_gate, shared_w_up, shared_w_down, final_norm):
    s = x.shape[1]
    ang_gqa = axial_angles(s, GQA_DIM)
    ang_diff = axial_angles(s, DIFF_QK_DIM)
    ang_mla = axial_angles(s, MLA_ROPE)
    xc = ctx
    for l in range(DEPTH):
        want_ctx = l < DEPTH - 1
        lam_init = 0.8 - 0.6 * math.exp(-0.3 * l)
        mod = jax.nn.silu(c) @ w_mod[l] + b_mod[l]
        mod_c = jax.nn.silu(c_ctx) @ w_mod[l] + b_mod[l]
        sh1, sc1, g1, sh2, sc2, g2 = jnp.split(mod[:, None, :], 6, axis=-1)
        sh1c, sc1c, g1c, sh2c, sc2c, g2c = jnp.split(mod_c, 6, axis=-1)

        h = modulate(rms_norm(x, norm_mix[l]), sh1, sc1)
        hc = modulate(rms_norm(xc, norm_mix[l]), sh1c, sc1c)
        u = split_cols(h @ w_in[l])
        uc = split_cols(hc @ w_in[l])
        a_lat, a_ctx = gqa_mixer(u[0], u[1], u[2], uc[0], uc[1], uc[2], gqa_q_norm[l], gqa_k_norm[l], ang_gqa, want_ctx)
        b_lat, b_ctx = na_mixer(u[3], u[4], u[5], uc[3], uc[4], uc[5], na_rel_bias[l], want_ctx)
        c_lat, c_ctx_out = diff_mixer(u[6], u[7], u[8], uc[6], uc[7], uc[8], diff_lq1[l], diff_lk1[l],
                                      diff_lq2[l], diff_lk2[l], diff_subln[l], lam_init, ang_diff, want_ctx)
        d_lat, d_ctx = mla_mixer(u[9], u[10], u[11], uc[9], uc[10], uc[11], mla_q_norm[l], mla_w_q_up[l],
                                 mla_kv_norm[l], mla_w_kv_up[l], ang_mla, want_ctx)
        x = x + g1 * (jnp.concatenate([a_lat, b_lat, c_lat, d_lat], axis=-1) @ w_out[l])

        h2 = modulate(rms_norm(x, norm_ffn[l]), sh2, sc2)
        x = x + g2 * moe_ffn(h2, router_w, router_b, moe_w_gate[l], moe_w_up[l], moe_w_down[l],
                             shared_w_gate[l], shared_w_up[l], shared_w_down[l])

        if want_ctx:
            xc = xc + g1c * (jnp.concatenate([a_ctx, b_ctx, c_ctx_out, d_ctx], axis=-1) @ w_out[l])
            h2c = modulate(rms_norm(xc, norm_ffn[l]), sh2c, sc2c)
            xc = xc + g2c * moe_ffn(h2c, router_w, router_b, moe_w_gate[l], moe_w_up[l], moe_w_down[l],
                                    shared_w_gate[l], shared_w_up[l], shared_w_down[l])
    return rms_norm(x, final_norm)
```

```cpp
#include <hip/hip_runtime.h>
#include <cstdio>
#include <cstdint>

#define LAS __attribute__((address_space(3)))
#define GAS __attribute__((address_space(1)))
typedef unsigned short bf16_t;
typedef short bf16x8 __attribute__((ext_vector_type(8)));
typedef short s16x4 __attribute__((ext_vector_type(4)));
typedef short v4i16_t __attribute__((ext_vector_type(4)));
typedef float f32x2 __attribute__((ext_vector_type(2)));
typedef float f32x4 __attribute__((ext_vector_type(4)));
typedef float f32x16 __attribute__((ext_vector_type(16)));
typedef unsigned u32x2 __attribute__((ext_vector_type(2)));
typedef unsigned u32x4 __attribute__((ext_vector_type(4)));
typedef __bf16 bf16x2_t __attribute__((ext_vector_type(2)));

constexpr int DM = 1024, NBATCH = 4, SEQ = 8192, CTXL = 256, SEG = SEQ + CTXL, MROWS = NBATCH * SEG, NTILE = MROWS / 256;
constexpr int NLAYER = 2, INCOLS = 2400, LDU = 3328, NEXP = 16;
constexpr int A_Q = 0, A_K = 256, A_V = 384, B_Q = 512, B_K = 768, B_V = 1024, C_Q = 1280, C_K = 1536, C_V = 1792;
constexpr int D_CQ = 2048, D_CKV = 2240, D_KPE = 2368, D_Q = 2400, D_KN = 2784, D_V = 3040, U_PAD0 = 3296;
constexpr float EPS = 1e-6f, LOG2E = 1.4426950408889634f;
constexpr float QS32 = 0.17677669529663687f * LOG2E, QS64 = 0.125f * LOG2E, QS96 = 0.10206207261596577f * LOG2E;
constexpr int SH_OFF = 71680, SLOT_ROWS = SH_OFF + MROWS;

constexpr size_t MiB = 1u << 20;
constexpr size_t WS_CTL = 0, CTL_ZERO_BYTES = 1 * MiB;
constexpr size_t WS_MOD = 1 * MiB;
constexpr size_t WS_LAM = WS_MOD + 256 * 1024;
constexpr size_t WS_LIST = 2 * MiB;
constexpr size_t WS_WL = 5 * MiB;
constexpr size_t WS_RSLOT = 8 * MiB;
constexpr size_t WS_XC = 9 * MiB;
constexpr size_t WS_WINT = 16 * MiB;
constexpr size_t WS_WOUTT = 29 * MiB;
constexpr size_t WS_WGU = 33 * MiB;
constexpr size_t WS_WDN = 67 * MiB;
constexpr size_t WS_H = 84 * MiB;
constexpr size_t WS_U = 150 * MiB;
constexpr size_t WS_ACT = 365 * MiB;
constexpr size_t WS_X1 = 418 * MiB;
constexpr size_t WS_END = 485 * MiB;
constexpr size_t WS_DRY = 488 * MiB;
static_assert(WS_WINT + (size_t)NLAYER * LDU * DM * 2 <= WS_WOUTT && WS_WGU + (size_t)NLAYER * 17 * 512 * 1024 * 2 <= WS_WDN && WS_WDN + (size_t)NLAYER * 17 * 1024 * 256 * 2 <= WS_H, "ws map");
static_assert(WS_H + (size_t)MROWS * DM * 2 <= WS_U && WS_U + (size_t)MROWS * LDU * 2 <= WS_ACT && WS_U + (size_t)SLOT_ROWS * 1024 * 2 <= WS_ACT && WS_ACT + (size_t)SLOT_ROWS * 256 * 2 <= WS_X1 && WS_X1 + (size_t)MROWS * DM * 2 <= WS_END, "ws map");
constexpr int CW_BAR = 4096;
constexpr int CW_QHEAD = 16384;
constexpr int CW_ECNT = 32768;

constexpr int RING_BYTES = 147456, MISC_OFF = 147456, LDS_BYTES = 151552;
constexpr int MISC_BARW = MISC_OFF + 32;
constexpr int MISC_POP = MISC_OFF + 64;
constexpr int MISC_TB = MISC_OFF + 256;
constexpr int MISC_T2E = MISC_OFF + 512;

__device__ __forceinline__ int lane_fresh() { int l; asm volatile("v_mbcnt_lo_u32_b32 %0, -1, 0\n\tv_mbcnt_hi_u32_b32 %0, -1, %0" : "=v"(l)); return l; }
__device__ __forceinline__ unsigned cvtpk(float lo, float hi) { f32x2 v = {lo, hi}; bf16x2_t b = __builtin_convertvector(v, bf16x2_t); return __builtin_bit_cast(unsigned, b); }
__device__ __forceinline__ float bf_lo(unsigned w) { return __uint_as_float(w << 16); }
__device__ __forceinline__ float bf_hi(unsigned w) { return __uint_as_float(w & 0xffff0000u); }
__device__ __forceinline__ float wave_sum(float v) {
    v += __int_as_float(__builtin_amdgcn_update_dpp(0, __float_as_int(v), 0xB1, 0xf, 0xf, true));
    v += __int_as_float(__builtin_amdgcn_update_dpp(0, __float_as_int(v), 0x4E, 0xf, 0xf, true));
    v += __int_as_float(__builtin_amdgcn_update_dpp(0, __float_as_int(v), 0x141, 0xf, 0xf, true));
    v += __int_as_float(__builtin_amdgcn_update_dpp(0, __float_as_int(v), 0x140, 0xf, 0xf, true));
    { auto p = __builtin_amdgcn_permlane16_swap(__float_as_uint(v), __float_as_uint(v), false, false); v = __uint_as_float(p[0]) + __uint_as_float(p[1]); }
    { auto p = __builtin_amdgcn_permlane32_swap(__float_as_uint(v), __float_as_uint(v), false, false); v = __uint_as_float(p[0]) + __uint_as_float(p[1]); }
    return v;
}
#define DPPF(x_, c_) __int_as_float(__builtin_amdgcn_update_dpp(0, __float_as_int(x_), (c_), 0xf, 0xf, true))
__device__ __forceinline__ float lane_xor1(float x) { return DPPF(x, 0xB1); }
__device__ __forceinline__ float lane_xor2(float x) { return DPPF(x, 0x4E); }
__device__ __forceinline__ float lane_xor4(float x) { const float y = DPPF(x, 0x141); return DPPF(y, 0x1B); }
__device__ __forceinline__ float lane_xor8(float x) { return DPPF(x, 0x128); }
__device__ __forceinline__ float row16_sum(float v) { v += DPPF(v, 0xB1); v += DPPF(v, 0x4E); v += DPPF(v, 0x141); v += DPPF(v, 0x140); return v; }
__device__ __forceinline__ int crow(int r, int hi) { return (r & 3) + 8 * (r >> 2) + 4 * hi; }
#define LDS_WAIT() asm volatile("s_waitcnt lgkmcnt(0)" ::: "memory")

#define XB_TMO      128
#define XB_XCNT(j)  (256  + 64 * (j))
#define XB_XSUB(j)  (1280 + 64 * (j))
#define XB_XGEN(j)  (2304 + 64 * (j))
#define XB_TOP      3328
#define XB_TOPGEN   3392
#define XCD_BAR_WORDS 3456
#define XB_SPIN_CAP (1u << 18)
__device__ __forceinline__ unsigned xb_ld(unsigned* p)              { return __hip_atomic_load(p, __ATOMIC_RELAXED, __HIP_MEMORY_SCOPE_AGENT); }
__device__ __forceinline__ unsigned xb_add(unsigned* p, unsigned v) { return __hip_atomic_fetch_add(p, v, __ATOMIC_RELAXED, __HIP_MEMORY_SCOPE_AGENT); }
__device__ __forceinline__ unsigned xb_xcc_id() { return (unsigned)__builtin_amdgcn_s_getreg((3 << 11) | 20) & 0xFu; }
#define XB_SPIN(cond, bar) do { unsigned _sp = 0; while (cond) { __builtin_amdgcn_s_sleep(1); \
    if ((++_sp & 255u) == 0u) { if (xb_ld(&(bar)[XB_TMO])) break; if (_sp > XB_SPIN_CAP) { atomicAdd(&(bar)[XB_TMO], 1u); break; } } } } while (0)
struct XcdBarrier { unsigned* bar; unsigned x; volatile LAS unsigned* st; };
__device__ __forceinline__ bool is_t0(int wv) { return wv == 0 && lane_fresh() == 0; }
__device__ __forceinline__ XcdBarrier xcd_barrier_post(unsigned* bar, volatile LAS unsigned* st, int wv) {
    XcdBarrier b; b.bar = bar; b.x = xb_xcc_id(); b.st = st;
    if (is_t0(wv)) (void)xb_add(&bar[XB_XCNT(b.x)], 1u);
    return b;
}
__device__ __forceinline__ void xcd_barrier_complete(unsigned* bar, unsigned x, unsigned& nloc, unsigned& nx) {
    const unsigned G = gridDim.x * gridDim.y * gridDim.z;
    unsigned sum, cnt, mine, sp = 0u;
    for (;;) {
        sum = 0u; cnt = 0u; mine = 0u;
#pragma unroll
        for (unsigned j = 0; j < 16; ++j) { const unsigned c = xb_ld(&bar[XB_XCNT(j)]); sum += c; cnt += (c > 0u) ? 1u : 0u; mine = (j == x) ? c : mine; }
        if (sum == G) break;
        __builtin_amdgcn_s_sleep(1);
        if ((++sp & 255u) == 0u) { if (xb_ld(&bar[XB_TMO])) break; if (sp > XB_SPIN_CAP) { atomicAdd(&bar[XB_TMO], 1u); break; } }
    }
    nloc = mine > 0u ? mine : 1u; nx = cnt > 0u ? cnt : 1u;
}
__device__ __forceinline__ void xcd_barrier(const XcdBarrier& b, int wv) {
    asm volatile("s_waitcnt vmcnt(0)" ::: "memory");
    __syncthreads();
    if (is_t0(wv)) {
        unsigned* bar = b.bar;
        __builtin_amdgcn_s_waitcnt(0);
        unsigned nloc = b.st[0], nx = b.st[1];
        if (nloc == 0u) { xcd_barrier_complete(bar, b.x, nloc, nx); b.st[0] = nloc; b.st[1] = nx; }
        const unsigned old = xb_add(&bar[XB_XSUB(b.x)], 1u);
        const unsigned gen = old / nloc;
        if (old + 1u == (gen + 1u) * nloc) {
            __builtin_amdgcn_fence(__ATOMIC_RELEASE, "agent");
            asm volatile("s_waitcnt vmcnt(0)" ::: "memory");
            const unsigned og = xb_add(&bar[XB_TOP], 1u);
            const unsigned tg = og / nx;
            if (og + 1u == (tg + 1u) * nx) xb_add(&bar[XB_TOPGEN], 1u);
            else XB_SPIN(xb_ld(&bar[XB_TOPGEN]) == tg, bar);
            __builtin_amdgcn_fence(__ATOMIC_ACQUIRE, "agent");
            xb_add(&bar[XB_XGEN(b.x)], 1u);
            asm volatile("s_waitcnt vmcnt(0)" ::: "memory");
        } else {
            XB_SPIN(xb_ld(&bar[XB_XGEN(b.x)]) == gen, bar);
            __builtin_amdgcn_fence(__ATOMIC_ACQUIRE, "agent");
            asm volatile("s_waitcnt vmcnt(0)" ::: "memory");
        }
    }
    __syncthreads();
}

struct Args {
    const float* x; const float* c; const float* ctx; const float* c_ctx; const float* w_mod; const float* b_mod;
    const float* norm_mix; const float* norm_ffn; const float* w_in; const float* w_out;
    const float* gqa_qn; const float* gqa_kn; const float* relb; const float* lq1; const float* lk1; const float* lq2; const float* lk2; const float* subln;
    const float* mla_qn; const float* mla_wqu; const float* mla_kvn; const float* mla_wkvu; const float* router_w; const float* router_b;
    const float* wg; const float* wu; const float* wd; const float* sg; const float* su; const float* sd; const float* final_norm;
    float* out; unsigned char* ws;
};

typedef const __attribute__((address_space(4))) Args* KA;
__device__ __forceinline__ KA fresh_args() { KA p = (KA)__builtin_amdgcn_kernarg_segment_ptr(); asm volatile("" : "+s"(p)); return p; }
__device__ __forceinline__ int fresh_tid(int wv) { return wv * 64 + lane_fresh(); }
__device__ __forceinline__ const float* xrow_in(const float* XL, const float* XC, int R) {
    const int b = R / SEG, t = R - b * SEG;
    return t < SEQ ? XL + ((size_t)b * SEQ + t) * DM : XC + ((size_t)b * CTXL + (t - SEQ)) * DM;
}
__device__ __forceinline__ float* xrow_out(float* XL, float* XC, int R) {
    const int b = R / SEG, t = R - b * SEG;
    return t < SEQ ? XL + ((size_t)b * SEQ + t) * DM : XC + ((size_t)b * CTXL + (t - SEQ)) * DM;
}

namespace pg8 {
constexpr int BM = 256, BK = 64, HALF = 128, HTB = HALF * BK * 2, STAGE_BYTES = 8 * HTB, NXCD = 8, WGM = 8;
__device__ __forceinline__ int lds_byte(int r, int c) { const int st = (r >> 4) * 2 + (c >> 5), rr = r & 15, cc = c & 31, ob = rr * 64 + cc * 2; return st * 1024 + (ob ^ (((ob >> 9) & 1) << 5)); }
__device__ __forceinline__ void stage_rc(int b, int& R, int& C) { const int st = b / 1024, sb = b % 1024, swz = sb ^ (((sb >> 9) & 1) << 5); R = (st >> 1) * 16 + swz / 64; C = (st & 1) * 32 + (swz % 64) / 2; }
__device__ __forceinline__ int perm32(int rho) { const int n = rho >> 4, i = rho & 15; return 8 * (i >> 2) + 4 * n + (i & 3); }
struct Unit { int pm, pn, e, lt; };
struct StaticOrder {
    int nM, nN, nwg, G, c;
    __device__ void init(int nM_, int nN_, int G_, int c_) { nM = nM_; nN = nN_; nwg = nM * nN; G = G_; c = c_; }
    __device__ bool next(int i, Unit& u) const {
        const long L = (long)i * G + c; if (L >= nwg) return false;
        int wgid = (int)L; { const int q = nwg / NXCD, r = nwg % NXCD, xcd = wgid % NXCD, off = wgid / NXCD; wgid = (xcd < r ? xcd * (q + 1) : r * (q + 1) + (xcd - r) * q) + off; }
        const int nig = WGM * nN, gid = wgid / nig, fm = gid * WGM, gsz = (nM - fm) < WGM ? (nM - fm) : WGM;
        u.pm = fm + ((wgid % nig) % gsz); u.pn = (wgid % nig) / gsz; u.e = 0; u.lt = 0; return true;
    }
};

template <class P>
__device__ __forceinline__ void gemm_phase(LAS unsigned char* lds, const P& pb, const int wv) {
    constexpr int K = P::K, nt = K / BK;
    static_assert(nt % 2 == 0 && nt >= 2, "K must be a multiple of 128");
    const int tid = fresh_tid(wv), wid = __builtin_amdgcn_readfirstlane(tid >> 6), lane = tid & 63, wr = wid >> 2, wc = wid & 3, fr = lane & 15, fq = lane >> 4;
    int Rr[2]; unsigned cb[2], voffB[2];
#pragma unroll
    for (int i = 0; i < 2; ++i) { int R, C; stage_rc(tid * 16 + i * 8192, R, C); const int Rb = P::PERM ? ((R & ~31) + perm32(R & 31)) : R;
        Rr[i] = R; cb[i] = (unsigned)C * 2u; voffB[i] = (unsigned)(Rb * K + C) * 2u; }
    constexpr size_t kstep = (size_t)(BK * 2);
    constexpr size_t hstep = (size_t)HALF * K * 2;
    const unsigned ldsw = (unsigned)wid * 1024u;
    const int aoff = lds_byte(wr * 64 + fr, fq * 8), boff = lds_byte(wc * 32 + fr, fq * 8);
    const char* Abase = pb.a_base();
#define PG8_SA(b, h) (((b) * 2 + (h)) * HTB)
#define PG8_SB(b, h) ((4 + (b) * 2 + (h)) * HTB)
#define PG8_STAGE(bufoff, gbase, voff) do { _Pragma("unroll") for (int _i = 0; _i < 2; ++_i) \
        __builtin_amdgcn_global_load_lds((const unsigned*)((const char*)(gbase) + (voff)[_i]), (LAS unsigned*)(lds + (bufoff) + ldsw + _i * 8192), 16, 0, 0); } while (0)
#define PG8_STAGE_A(bufoff, offs, kb) do { const char* _sb = Abase + (size_t)(kb); _Pragma("unroll") for (int _i = 0; _i < 2; ++_i) \
        __builtin_amdgcn_global_load_lds((const unsigned*)(_sb + (offs)[_i]), (LAS unsigned*)(lds + (bufoff) + ldsw + _i * 8192), 16, 0, 0); } while (0)
#define PG8_LDA(dst, b, h) do { _Pragma("unroll") for (int m = 0; m < 4; ++m) _Pragma("unroll") for (int k = 0; k < 2; ++k) dst[m][k] = *(const LAS bf16x8*)(lds + PG8_SA(b, h) + aoff + m * 2048 + k * 1024); } while (0)
#define PG8_LDB(dst, b, h) do { _Pragma("unroll") for (int n = 0; n < 2; ++n) _Pragma("unroll") for (int k = 0; k < 2; ++k) dst[n][k] = *(const LAS bf16x8*)(lds + PG8_SB(b, h) + boff + n * 2048 + k * 1024); } while (0)
#define PG8_MMA(ai, bj, At, Bt) do { __builtin_amdgcn_s_setprio(1); _Pragma("unroll") for (int m = 0; m < 4; ++m) _Pragma("unroll") for (int n = 0; n < 2; ++n) _Pragma("unroll") for (int k = 0; k < 2; ++k) \
        acc[ai][bj][m][n] = __builtin_amdgcn_mfma_f32_16x16x32_bf16(Bt[n][k], At[m][k], acc[ai][bj][m][n], 0, 0, 0); __builtin_amdgcn_s_setprio(0); } while (0)
#define PG8_WAIT_V(n) asm volatile("s_waitcnt vmcnt(" #n ")" ::: "memory")
#define PG8_WAIT_L(n) asm volatile("s_waitcnt lgkmcnt(" #n ")" ::: "memory")
#define PG8_BAR __builtin_amdgcn_s_barrier()
#define PG8_SCHED __builtin_amdgcn_sched_barrier(0)
    Unit cur, nxt; int ui = 0;
    if (!pb.next(0, cur)) return;
    f32x4 acc[2][2][4][2];
#pragma unroll
    for (int a = 0; a < 2; ++a)
#pragma unroll
        for (int b = 0; b < 2; ++b)
#pragma unroll
            for (int m = 0; m < 4; ++m)
#pragma unroll
                for (int n = 0; n < 2; ++n) acc[a][b][m][n] = (f32x4){0.f, 0.f, 0.f, 0.f};
    bf16x8 At[4][2], B0[2][2], B1[2][2];
    unsigned ao[2][2];
    pb.a_offs(cur, Rr, ao);
#pragma unroll
    for (int h = 0; h < 2; ++h)
#pragma unroll
        for (int i = 0; i < 2; ++i) ao[h][i] += cb[i];
    const char* cB = pb.b_base(cur);
    PG8_STAGE(PG8_SB(0, 0), cB, voffB); PG8_STAGE(PG8_SB(0, 1), cB + hstep, voffB); PG8_STAGE_A(PG8_SA(0, 0), ao[0], 0); PG8_STAGE_A(PG8_SA(0, 1), ao[1], 0);
    if (wr == 1) PG8_BAR;
    PG8_WAIT_V(2); PG8_BAR;
    PG8_STAGE(PG8_SB(1, 0), cB + kstep, voffB); PG8_STAGE_A(PG8_SA(1, 0), ao[0], kstep); PG8_STAGE(PG8_SB(1, 1), cB + hstep + kstep, voffB);
    PG8_WAIT_V(6); PG8_BAR;
    for (;;) {
        const bool has_next = pb.next(ui + 1, nxt);
        const char* nB = has_next ? pb.b_base(nxt) : cB;
#pragma unroll 1
        for (int t = 0; t < nt; t += 2) {
            const bool last = (t == nt - 2);
            const size_t k1 = (size_t)(t + 1) * kstep;
            PG8_LDB(B0, 0, 0); PG8_LDB(B1, 0, 1); PG8_SCHED; PG8_LDA(At, 0, 0); PG8_STAGE_A(PG8_SA(1, 1), ao[1], k1);
            const char* b2 = last ? nB : cB + (size_t)(t + 2) * kstep; const char* b3 = b2 + kstep;
            size_t k2 = (size_t)(t + 2) * kstep;
            if (last) { k2 = 0;
                if (has_next) { pb.a_offs(nxt, Rr, ao);
#pragma unroll
                    for (int h = 0; h < 2; ++h)
#pragma unroll
                        for (int i = 0; i < 2; ++i) ao[h][i] += cb[i]; } }
            const size_t k3 = k2 + kstep;
            PG8_WAIT_V(8); PG8_WAIT_L(0); PG8_BAR; PG8_MMA(0, 0, At, B0); PG8_MMA(0, 1, At, B1); PG8_BAR; PG8_SCHED;
            PG8_LDA(At, 0, 1); PG8_STAGE(PG8_SB(0, 0), b2, voffB); PG8_STAGE(PG8_SB(0, 1), b2 + hstep, voffB); PG8_STAGE_A(PG8_SA(0, 0), ao[0], k2);
            PG8_WAIT_V(8); PG8_WAIT_L(0); PG8_BAR; PG8_MMA(1, 0, At, B0); PG8_MMA(1, 1, At, B1); PG8_BAR; PG8_SCHED;
            PG8_LDB(B0, 1, 0); PG8_LDB(B1, 1, 1); PG8_SCHED; PG8_LDA(At, 1, 0); PG8_STAGE_A(PG8_SA(0, 1), ao[1], k2);
            PG8_WAIT_V(8); PG8_WAIT_L(0); PG8_BAR; PG8_MMA(0, 0, At, B0); PG8_MMA(0, 1, At, B1); PG8_BAR; PG8_SCHED;
            PG8_LDA(At, 1, 1); PG8_STAGE(PG8_SB(1, 0), b3, voffB); PG8_STAGE(PG8_SB(1, 1), b3 + hstep, voffB); PG8_STAGE_A(PG8_SA(1, 0), ao[0], k3);
            PG8_WAIT_V(8); PG8_WAIT_L(0); PG8_BAR; PG8_MMA(1, 0, At, B0); PG8_MMA(1, 1, At, B1); PG8_BAR; PG8_SCHED;
        }
        if (wr == 0) PG8_BAR;
        pb.epi(acc, cur, wr, wc, fr, fq);
        if (!has_next) break;
#pragma unroll
        for (int a = 0; a < 2; ++a)
#pragma unroll
            for (int b = 0; b < 2; ++b)
#pragma unroll
                for (int m = 0; m < 4; ++m)
#pragma unroll
                    for (int n = 0; n < 2; ++n) acc[a][b][m][n] = (f32x4){0.f, 0.f, 0.f, 0.f};
        cur = nxt; cB = nB; ++ui;
        if (wr == 1) PG8_BAR;
    }
    PG8_WAIT_V(0);
    PG8_BAR;
#undef PG8_SA
#undef PG8_SB
#undef PG8_STAGE
#undef PG8_STAGE_A
#undef PG8_LDA
#undef PG8_LDB
#undef PG8_MMA
#undef PG8_WAIT_V
#undef PG8_WAIT_L
#undef PG8_BAR
#undef PG8_SCHED
}
}
using pg8::Unit;
typedef f32x4 Acc[2][2][4][2];

struct ProbIn {
    static constexpr int K = 1024; static constexpr bool PERM = true;
    pg8::StaticOrder S; const bf16_t* H; const bf16_t* W; bf16_t* U;
    __device__ __forceinline__ bool next(int i, Unit& u) const { return S.next(i, u); }
    __device__ __forceinline__ const char* a_base() const { return (const char*)H; }
    __device__ __forceinline__ void a_offs(const Unit& u, const int (&R)[2], unsigned (&off)[2][2]) const {
#pragma unroll
        for (int h = 0; h < 2; ++h)
#pragma unroll
            for (int i = 0; i < 2; ++i) off[h][i] = (unsigned)(u.pm * 256 + h * 128 + R[i]) * 2048u; }
    __device__ __forceinline__ const char* b_base(const Unit& u) const { return (const char*)(W + (size_t)u.pn * 256 * 1024); }
    __device__ __forceinline__ void epi(const Acc& acc, const Unit& u, int wr, int wc, int fr, int fq) const {
        const int row0 = u.pm * 256 + wr * 64 + fr, col0 = u.pn * 256 + wc * 32 + 8 * fq;
        const float qs = u.pn == 2 ? QS64 : (u.pn == 5 ? QS32 : 1.f);
#pragma unroll
        for (int ai = 0; ai < 2; ++ai)
#pragma unroll
            for (int m = 0; m < 4; ++m) { bf16_t* rowp = U + (size_t)(row0 + ai * 128 + m * 16) * LDU + col0;
#pragma unroll
                for (int bj = 0; bj < 2; ++bj) { const f32x4 v0 = acc[ai][bj][m][0] * qs, v1 = acc[ai][bj][m][1] * qs;
                    u32x4 w; w.x = cvtpk(v0[0], v0[1]); w.y = cvtpk(v0[2], v0[3]); w.z = cvtpk(v1[0], v1[1]); w.w = cvtpk(v1[2], v1[3]);
                    *(u32x4*)(rowp + bj * 128) = w; } }
    }
};
struct ProbOut {
    static constexpr int K = 1024; static constexpr bool PERM = true;
    pg8::StaticOrder S; const bf16_t* AO; const bf16_t* W; const float* XLin; const float* XCin; bf16_t* X1; const float* mod; int latent_only;
    __device__ __forceinline__ int tile(int jm) const { return latent_only ? jm + jm / 32 : jm; }
    __device__ __forceinline__ bool next(int i, Unit& u) const { return S.next(i, u); }
    __device__ __forceinline__ const char* a_base() const { return (const char*)AO; }
    __device__ __forceinline__ void a_offs(const Unit& u, const int (&R)[2], unsigned (&off)[2][2]) const {
        const int p = tile(u.pm);
#pragma unroll
        for (int h = 0; h < 2; ++h)
#pragma unroll
            for (int i = 0; i < 2; ++i) off[h][i] = (unsigned)(p * 256 + h * 128 + R[i]) * 2048u; }
    __device__ __forceinline__ const char* b_base(const Unit& u) const { return (const char*)(W + (size_t)u.pn * 256 * 1024); }
    __device__ __forceinline__ void epi(const Acc& acc, const Unit& u, int wr, int wc, int fr, int fq) const {
        const int p = tile(u.pm), b = p / 33, tp = p - b * 33, cls = tp == 32 ? 4 : b;
        const float* xin = nullptr;
        if (XLin) xin = tp < 32 ? XLin + ((size_t)b * SEQ + tp * 256) * DM : XCin + (size_t)b * CTXL * DM;
        bf16_t* xo = X1 + (size_t)p * 256 * DM;
        const float* g1 = mod + cls * 6144 + 2048;
        const int col0 = u.pn * 256 + wc * 32 + 8 * fq;
        f32x4 gv[2][2];
#pragma unroll
        for (int bj = 0; bj < 2; ++bj)
#pragma unroll
            for (int n = 0; n < 2; ++n) gv[bj][n] = *(const f32x4*)(g1 + col0 + bj * 128 + n * 4);
#pragma unroll
        for (int ai = 0; ai < 2; ++ai)
#pragma unroll
            for (int m = 0; m < 4; ++m) { const size_t off = (size_t)(ai * 128 + wr * 64 + m * 16 + fr) * DM + col0;
#pragma unroll
                for (int bj = 0; bj < 2; ++bj) { f32x4 x0, x1;
                    if (xin) { x0 = *(const f32x4*)(xin + off + bj * 128); x1 = *(const f32x4*)(xin + off + bj * 128 + 4); }
                    else { const u32x4 w = *(const u32x4*)(xo + off + bj * 128); x0 = (f32x4){bf_lo(w.x), bf_hi(w.x), bf_lo(w.y), bf_hi(w.y)}; x1 = (f32x4){bf_lo(w.z), bf_hi(w.z), bf_lo(w.w), bf_hi(w.w)}; }
                    const f32x4 v0 = x0 + gv[bj][0] * acc[ai][bj][m][0], v1 = x1 + gv[bj][1] * acc[ai][bj][m][1];
                    u32x4 o; o.x = cvtpk(v0[0], v0[1]); o.y = cvtpk(v0[2], v0[3]); o.z = cvtpk(v1[0], v1[1]); o.w = cvtpk(v1[2], v1[3]);
                    *(u32x4*)(xo + off + bj * 128) = o; } }
    }
};
struct MoeSched {
    int G, c, ncol, nrt, nsh, latent_only; const LAS int* t2e; const LAS int* tb; const LAS int* cn;
    __device__ __forceinline__ int shtile(int jm) const { return latent_only ? jm + jm / 32 : jm; }
    __device__ __forceinline__ bool next(int i, Unit& u) const {
        const int L = i * G + c; if (L >= (nrt + nsh) * ncol) return false;
        const int rt = L / ncol; u.pn = L - rt * ncol;
        if (rt < nrt) { u.pm = rt; u.e = t2e[rt]; u.lt = rt - tb[u.e]; } else { u.pm = 1024 + shtile(rt - nrt); u.e = 16; u.lt = 0; }
        return true;
    }
};
struct ProbGU {
    static constexpr int K = 1024; static constexpr bool PERM = true;
    MoeSched S; const bf16_t* H; const bf16_t* W; const unsigned* list; bf16_t* ACT;
    __device__ __forceinline__ bool next(int i, Unit& u) const { return S.next(i, u); }
    __device__ __forceinline__ const char* a_base() const { return (const char*)H; }
    __device__ __forceinline__ void a_offs(const Unit& u, const int (&R)[2], unsigned (&off)[2][2]) const {
        if (u.pm < 1024) { const int cnt = S.cn[u.e]; const unsigned* lp = list + (size_t)u.e * MROWS;
#pragma unroll
            for (int h = 0; h < 2; ++h)
#pragma unroll
                for (int i = 0; i < 2; ++i) { const int pos = u.lt * 256 + h * 128 + R[i]; const unsigned src = pos < cnt ? lp[pos] : 0u; off[h][i] = src * 2048u; }
        } else { const int p = u.pm - 1024;
#pragma unroll
            for (int h = 0; h < 2; ++h)
#pragma unroll
                for (int i = 0; i < 2; ++i) off[h][i] = (unsigned)(p * 256 + h * 128 + R[i]) * 2048u; }
    }
    __device__ __forceinline__ const char* b_base(const Unit& u) const { return (const char*)(W + ((size_t)u.e * 512 + u.pn * 256) * 1024); }
    __device__ __forceinline__ void epi(const Acc& acc, const Unit& u, int wr, int wc, int fr, int fq) const {
        const int srow0 = (u.pm < 1024 ? u.pm * 256 : SH_OFF + (u.pm - 1024) * 256) + wr * 64 + fr, col0 = u.pn * 128 + wc * 32 + 8 * fq;
#pragma unroll
        for (int ai = 0; ai < 2; ++ai)
#pragma unroll
            for (int m = 0; m < 4; ++m) { float v[8];
#pragma unroll
                for (int n = 0; n < 2; ++n)
#pragma unroll
                    for (int j = 0; j < 4; ++j) { const float g = acc[ai][0][m][n][j], uu = acc[ai][1][m][n][j]; v[n * 4 + j] = g * __builtin_amdgcn_rcpf(1.f + __builtin_amdgcn_exp2f(-g * LOG2E)) * uu; }
                u32x4 w; w.x = cvtpk(v[0], v[1]); w.y = cvtpk(v[2], v[3]); w.z = cvtpk(v[4], v[5]); w.w = cvtpk(v[6], v[7]);
                *(u32x4*)(ACT + (size_t)(srow0 + ai * 128 + m * 16) * 256 + col0) = w; }
    }
};
struct ProbDN {
    static constexpr int K = 256; static constexpr bool PERM = true;
    MoeSched S; const bf16_t* ACT; const bf16_t* W; const float* wl; bf16_t* Y;
    __device__ __forceinline__ bool next(int i, Unit& u) const { return S.next(i, u); }
    __device__ __forceinline__ const char* a_base() const { return (const char*)ACT; }
    __device__ __forceinline__ void a_offs(const Unit& u, const int (&R)[2], unsigned (&off)[2][2]) const {
        const int sr = u.pm < 1024 ? u.pm * 256 : SH_OFF + (u.pm - 1024) * 256;
#pragma unroll
        for (int h = 0; h < 2; ++h)
#pragma unroll
            for (int i = 0; i < 2; ++i) off[h][i] = (unsigned)(sr + h * 128 + R[i]) * 512u; }
    __device__ __forceinline__ const char* b_base(const Unit& u) const { return (const char*)(W + ((size_t)u.e * 1024 + u.pn * 256) * 256); }
    __device__ __forceinline__ void epi(const Acc& acc, const Unit& u, int wr, int wc, int fr, int fq) const {
        const bool routed = u.pm < 1024;
        const int srow0 = (routed ? u.pm * 256 : SH_OFF + (u.pm - 1024) * 256) + wr * 64 + fr, col0 = u.pn * 256 + wc * 32 + 8 * fq;
        const int cnt = routed ? S.cn[u.e] : 0; const float* wp = wl + (size_t)(routed ? u.e : 0) * MROWS;
#pragma unroll
        for (int ai = 0; ai < 2; ++ai)
#pragma unroll
            for (int m = 0; m < 4; ++m) { const int rl = ai * 128 + wr * 64 + m * 16 + fr; float gw = 1.f;
                if (routed) { const int pos = u.lt * 256 + rl; gw = pos < cnt ? wp[pos] : 0.f; }
                bf16_t* rowp = Y + (size_t)(srow0 + ai * 128 + m * 16) * 1024 + col0;
#pragma unroll
                for (int bj = 0; bj < 2; ++bj) { const f32x4 v0 = acc[ai][bj][m][0] * gw, v1 = acc[ai][bj][m][1] * gw;
                    u32x4 w; w.x = cvtpk(v0[0], v0[1]); w.y = cvtpk(v0[2], v0[3]); w.z = cvtpk(v1[0], v1[1]); w.w = cvtpk(v1[2], v1[3]);
                    *(u32x4*)(rowp + bj * 128) = w; } }
    }
};

constexpr int AT_K = 0, AT_KB = 13312, AT_V = 26624, AT_VB = 8192, AT_WS = 43008, AT_OST = 45056, AT_BT = 77824, AT_O1 = 79872;
static_assert(AT_O1 + 8 * 8192 <= RING_BYTES, "attention LDS map");
__device__ __forceinline__ s16x4 vtr(const LAS unsigned char* p) { return __builtin_bit_cast(s16x4, __builtin_amdgcn_ds_read_tr16_b64_v4i16((LAS v4i16_t*)p)); }

__device__ __forceinline__ float max3f(float a, float b, float c) { float r; asm("v_max3_f32 %0, %1, %2, %3" : "=v"(r) : "v"(a), "v"(b), "v"(c)); return r; }
__device__ __forceinline__ float max2f(float a, float b) { float r; asm("v_max_f32_e32 %0, %1, %2" : "=v"(r) : "v"(a), "v"(b)); return r; }
__device__ __forceinline__ void glds16(const char* sbase  , unsigned voff  , unsigned lds_dst) {
    asm volatile("s_mov_b32 m0, %2\n\tglobal_load_lds_dwordx4 %0, %1" :: "v"(voff), "s"(sbase), "s"(lds_dst) : "memory"); }
#define GLDS_COVER() asm volatile("s_nop 4" ::: "memory")
__device__ __forceinline__ void attn_core_na(f32x16 (&o)[2], LAS unsigned char* lds, const bf16_t* Qlane, const bf16_t* Kb, const bf16_t* Vb,
                                             int rlo, int n1, int na_rq, const int tid, const int wid) {
    const int lane = tid & 63, r32 = lane & 31, hi = lane >> 5;
    bf16x8 qr[4];
#pragma unroll
    for (int ks = 0; ks < 4; ++ks) qr[ks] = *(const bf16x8*)(Qlane + ks * 16);
    const unsigned voffK = (unsigned)(lane * LDU + wid * 8) * 2u;
    const unsigned voffV = (unsigned)((16 * (wid & 3) + (lane >> 2)) * LDU + (4 * (wid >> 2) + (lane & 3)) * 8) * 2u;
    const unsigned lds0 = (unsigned)(uintptr_t)lds;
    LAS float* wsf = (LAS float*)(lds + AT_WS) + wid * 64;
    const LAS unsigned char* kb0 = lds + AT_K + hi * 1024 + r32 * 16;
    const LAS unsigned char* vb0 = lds + AT_V + ((lane >> 4) & 1) * 32 + (lane & 3) * 8 + (4 * hi + ((lane & 15) >> 2)) * 64;
    const int na_r0 = na_rq - 4 < 0 ? 0 : (na_rq - 4 > 120 ? 120 : na_rq - 4);
    const int na_cq = 32 * (wid & 1) + r32, na_c0 = na_cq - 8 < 0 ? 0 : (na_cq - 8 > 48 ? 48 : na_cq - 8);
    const int NT = n1 + 4;
#define NA_DMA(j, sl) do { const size_t ro_ = (size_t)((j) < n1 ? rlo + (j) : 128 + (j) - n1) * (64 * LDU * 2); \
        glds16((const char*)Kb + ro_, voffK, (unsigned)__builtin_amdgcn_readfirstlane((int)(lds0 + AT_K + (sl) * AT_KB + wid * 1024))); \
        glds16((const char*)Vb + ro_, voffV, (unsigned)__builtin_amdgcn_readfirstlane((int)(lds0 + AT_V + (sl) * AT_VB + wid * 1024))); } while (0)
#define NA_BAR() do { asm volatile("s_waitcnt vmcnt(0)" ::: "memory"); __syncthreads(); } while (0)
    float m_run = -1e30f;
    f32x16 ol = f32x16{};
    bf16x8 ones = {(short)0x3f80, (short)0x3f80, (short)0x3f80, (short)0x3f80, (short)0x3f80, (short)0x3f80, (short)0x3f80, (short)0x3f80};
    asm volatile("" : "+v"(ones));
    o[0] = f32x16{}; o[1] = f32x16{};
    __syncthreads();
    GLDS_COVER(); NA_DMA(0, 0);
    NA_BAR();
    for (int j = 0; j < NT; ++j) {
        const int bf = j & 1;
        if (j + 1 < NT) NA_DMA(j + 1, bf ^ 1);
        const int tile = j < n1 ? rlo + j : 128 + j - n1;
        const bool active = tile >= 128 || (tile >= na_r0 && tile <= na_r0 + 7);
        if (active) {
            __builtin_amdgcn_iglp_opt(0);
            f32x16 p0 = f32x16{}, p1 = f32x16{};
            const LAS unsigned char* kb = kb0 + bf * AT_KB;
#pragma unroll
            for (int ks = 0; ks < 4; ++ks) {
                const bf16x8 b0 = *(const LAS bf16x8*)(kb + ks * 2048), b1 = *(const LAS bf16x8*)(kb + ks * 2048 + 512);
                p0 = __builtin_amdgcn_mfma_f32_32x32x16_bf16(b0, qr[ks], p0, 0, 0, 0);
                p1 = __builtin_amdgcn_mfma_f32_32x32x16_bf16(b1, qr[ks], p1, 0, 0, 0);
            }
            if (tile < 128) {
                const LAS float* bt = (const LAS float*)(lds + AT_BT) + (tile - na_rq + 7) * 31 + 15 - na_cq;
#pragma unroll
                for (int r = 0; r < 16; ++r) {
                    const int ck0 = crow(r, hi), ck1 = ck0 + 32;
                    const bool v0 = (unsigned)(ck0 - na_c0) < 16u, v1 = (unsigned)(ck1 - na_c0) < 16u;
                    const float b0 = bt[v0 ? ck0 : na_c0], b1 = bt[v1 ? ck1 : na_c0];
                    p0[r] = v0 ? p0[r] + b0 : -1e30f;
                    p1[r] = v1 ? p1[r] + b1 : -1e30f;
                }
            }
            float pm;
            { asm volatile("s_nop 15\n\ts_nop 7" : "+v"(p0), "+v"(p1));
              float a_ = max3f(p0[0], p0[1], p1[0]), b_ = max3f(p0[2], p0[3], p1[1]); a_ = max3f(a_, p1[2], p1[3]);
#pragma unroll
              for (int r = 4; r < 16; r += 4) { a_ = max3f(a_, p0[r], p0[r + 1]); b_ = max3f(b_, p0[r + 2], p0[r + 3]); a_ = max3f(a_, p1[r], p1[r + 1]); b_ = max3f(b_, p1[r + 2], p1[r + 3]); }
              pm = max2f(a_, b_); auto rr = __builtin_amdgcn_permlane32_swap(__float_as_uint(pm), __float_as_uint(pm), false, false); pm = max2f(__uint_as_float(rr[0]), __uint_as_float(rr[1])); }
            if (!__all(pm - m_run <= 11.5f)) {
                const float mn = __builtin_fmaxf(m_run, pm), alpha = __builtin_amdgcn_exp2f(m_run - mn);
                m_run = mn;
                if (hi == 0) wsf[r32] = alpha;
#pragma unroll
                for (int r = 0; r < 16; ++r) { const float a = wsf[crow(r, hi)]; o[0][r] *= a; o[1][r] *= a; ol[r] *= a; }
            }
#pragma unroll
            for (int r = 0; r < 16; ++r) { p0[r] = __builtin_amdgcn_exp2f(p0[r] - m_run); p1[r] = __builtin_amdgcn_exp2f(p1[r] - m_run); }
            bf16x8 pa[4];
            { u32x4 w;
              w.x = cvtpk(p0[0], p0[1]); w.y = cvtpk(p0[2], p0[3]); w.z = cvtpk(p0[4], p0[5]); w.w = cvtpk(p0[6], p0[7]); pa[0] = __builtin_bit_cast(bf16x8, w);
              w.x = cvtpk(p0[8], p0[9]); w.y = cvtpk(p0[10], p0[11]); w.z = cvtpk(p0[12], p0[13]); w.w = cvtpk(p0[14], p0[15]); pa[1] = __builtin_bit_cast(bf16x8, w);
              w.x = cvtpk(p1[0], p1[1]); w.y = cvtpk(p1[2], p1[3]); w.z = cvtpk(p1[4], p1[5]); w.w = cvtpk(p1[6], p1[7]); pa[2] = __builtin_bit_cast(bf16x8, w);
              w.x = cvtpk(p1[8], p1[9]); w.y = cvtpk(p1[10], p1[11]); w.z = cvtpk(p1[12], p1[13]); w.w = cvtpk(p1[14], p1[15]); pa[3] = __builtin_bit_cast(bf16x8, w); }
            const LAS unsigned char* vb = vb0 + bf * AT_VB;
#pragma unroll
            for (int ks = 0; ks < 4; ++ks) {
                ol = __builtin_amdgcn_mfma_f32_32x32x16_bf16(pa[ks], ones, ol, 0, 0, 0);
#pragma unroll
                for (int d0 = 0; d0 < 2; ++d0) {
                    const s16x4 lo = vtr(vb + d0 * 4096 + ks * 1024), hh = vtr(vb + d0 * 4096 + ks * 1024 + 512);
                    const bf16x8 vf = {lo[0], lo[1], lo[2], lo[3], hh[0], hh[1], hh[2], hh[3]};
                    o[d0] = __builtin_amdgcn_mfma_f32_32x32x16_bf16(pa[ks], vf, o[d0], 0, 0, 0);
                }
            }
        }
        NA_BAR();
    }
#undef NA_DMA
#undef NA_BAR
#pragma unroll
    for (int r = 0; r < 16; ++r) { const float rl = __builtin_amdgcn_rcpf(ol[r]); o[0][r] *= rl; o[1][r] *= rl; }
}
template <int DK, bool NEGM = true>
__device__ __forceinline__ void attn_core2(f32x16 (&o)[2], LAS unsigned char* lds, const bf16_t* Qlane, const bf16_t* Kb, const bf16_t* K2b, const bf16_t* Vb,
                                           const int t0, const int NT, const int tid, const int wid) {
    constexpr int NKS = DK / 16;
    constexpr float THR2 = 11.5f;
    const int lane = tid & 63, r32 = lane & 31, hi = lane >> 5;
    bf16x8 qr[NKS];
#pragma unroll
    for (int ks = 0; ks < NKS; ++ks) qr[ks] = *(const bf16x8*)(Qlane + ks * 16);
    const unsigned voffK = (unsigned)(lane * LDU + wid * 8) * 2u;
    const unsigned voffV = (unsigned)((16 * (wid & 3) + (lane >> 2)) * LDU + (4 * (wid >> 2) + (lane & 3)) * 8) * 2u;
    const char* ksrc = (const char*)(Kb + (size_t)t0 * 64 * LDU);
    const char* ksrc2 = (const char*)(K2b + (size_t)t0 * 64 * LDU);
    const char* vsrc = (const char*)(Vb + (size_t)t0 * 64 * LDU);
    const bool kact = DK >= 64 || wid < 4, k2act = DK == 96 && wid < 4;
    LAS float* wsf = (LAS float*)(lds + AT_WS) + wid * 64;
    const LAS unsigned char* kb0 = lds + AT_K + hi * 1024 + r32 * 16;
    const LAS unsigned char* vb0 = lds + AT_V + ((lane >> 4) & 1) * 32 + (lane & 3) * 8 + (4 * hi + ((lane & 15) >> 2)) * 64;
    const unsigned lds0 = (unsigned)(uintptr_t)lds;
#define C2_DMAK(t, sl) do { const size_t ro_ = (size_t)(t) * (64 * LDU * 2); \
        if (kact) glds16(ksrc + ro_, voffK, (unsigned)__builtin_amdgcn_readfirstlane((int)(lds0 + AT_K + (sl) * AT_KB + wid * 1024))); \
        if (k2act) glds16(ksrc2 + ro_, voffK, (unsigned)__builtin_amdgcn_readfirstlane((int)(lds0 + AT_K + (sl) * AT_KB + (8 + wid) * 1024))); } while (0)
#define C2_DMAV(t, sl) do { glds16(vsrc + (size_t)(t) * (64 * LDU * 2), voffV, (unsigned)__builtin_amdgcn_readfirstlane((int)(lds0 + AT_V + (sl) * AT_VB + wid * 1024))); } while (0)
#define C2_BAR() do { asm volatile("s_waitcnt vmcnt(0)" ::: "memory"); __syncthreads(); } while (0)
#define C2_QKT(P0, P1, sl) do { const LAS unsigned char* kb_ = kb0 + (sl) * AT_KB; \
        _Pragma("unroll") for (int ks = 0; ks < NKS; ++ks) { \
            const bf16x8 b0_ = *(const LAS bf16x8*)(kb_ + ks * 2048), b1_ = *(const LAS bf16x8*)(kb_ + ks * 2048 + 512); \
            if (ks == 0) { if constexpr (NEGM) { P0 = __builtin_amdgcn_mfma_f32_32x32x16_bf16(b0_, qr[0], negm, 0, 0, 0); P1 = __builtin_amdgcn_mfma_f32_32x32x16_bf16(b1_, qr[0], negm, 0, 0, 0); } \
                           else { P0 = __builtin_amdgcn_mfma_f32_32x32x16_bf16(b0_, qr[0], f32x16{}, 0, 0, 0); P1 = __builtin_amdgcn_mfma_f32_32x32x16_bf16(b1_, qr[0], f32x16{}, 0, 0, 0); } } \
            else { P0 = __builtin_amdgcn_mfma_f32_32x32x16_bf16(b0_, qr[ks], P0, 0, 0, 0); P1 = __builtin_amdgcn_mfma_f32_32x32x16_bf16(b1_, qr[ks], P1, 0, 0, 0); } } } while (0)
#define C2_FINISH(P0, P1) do { \
        _Pragma("unroll") for (int r = 0; r < 16; ++r) P0[r] = __builtin_amdgcn_exp2f(NEGM ? P0[r] : P0[r] - mhat); \
        _Pragma("unroll") for (int r = 0; r < 16; ++r) P1[r] = __builtin_amdgcn_exp2f(NEGM ? P1[r] : P1[r] - mhat); \
        u32x4 w_; \
        w_.x = cvtpk(P0[0], P0[1]); w_.y = cvtpk(P0[2], P0[3]); w_.z = cvtpk(P0[4], P0[5]); w_.w = cvtpk(P0[6], P0[7]); pa0 = __builtin_bit_cast(bf16x8, w_); \
        w_.x = cvtpk(P0[8], P0[9]); w_.y = cvtpk(P0[10], P0[11]); w_.z = cvtpk(P0[12], P0[13]); w_.w = cvtpk(P0[14], P0[15]); pa1 = __builtin_bit_cast(bf16x8, w_); \
        w_.x = cvtpk(P1[0], P1[1]); w_.y = cvtpk(P1[2], P1[3]); w_.z = cvtpk(P1[4], P1[5]); w_.w = cvtpk(P1[6], P1[7]); pa2 = __builtin_bit_cast(bf16x8, w_); \
        w_.x = cvtpk(P1[8], P1[9]); w_.y = cvtpk(P1[10], P1[11]); w_.z = cvtpk(P1[12], P1[13]); w_.w = cvtpk(P1[14], P1[15]); pa3 = __builtin_bit_cast(bf16x8, w_); } while (0)
#define C2_VFR(d0, ks, L, H) do { L = vtr(vb_ + (d0) * 4096 + (ks) * 1024); H = vtr(vb_ + (d0) * 4096 + (ks) * 1024 + 512); } while (0)
#define C2_VF(L, H) (bf16x8){L[0], L[1], L[2], L[3], H[0], H[1], H[2], H[3]}
  \
#define C2_PV(sl) do { const LAS unsigned char* vb_ = vb0 + (sl) * AT_VB; s16x4 l0_, h0_, l1_, h1_, l2_, h2_, l3_, h3_; \
        C2_VFR(0, 0, l0_, h0_); C2_VFR(1, 0, l1_, h1_); \
        C2_VFR(0, 1, l2_, h2_); C2_VFR(1, 1, l3_, h3_); \
        ol = __builtin_amdgcn_mfma_f32_32x32x16_bf16(pa0, ones, ol, 0, 0, 0); o[0] = __builtin_amdgcn_mfma_f32_32x32x16_bf16(pa0, C2_VF(l0_, h0_), o[0], 0, 0, 0); o[1] = __builtin_amdgcn_mfma_f32_32x32x16_bf16(pa0, C2_VF(l1_, h1_), o[1], 0, 0, 0); \
        C2_VFR(0, 2, l0_, h0_); C2_VFR(1, 2, l1_, h1_); \
        ol = __builtin_amdgcn_mfma_f32_32x32x16_bf16(pa1, ones, ol, 0, 0, 0); o[0] = __builtin_amdgcn_mfma_f32_32x32x16_bf16(pa1, C2_VF(l2_, h2_), o[0], 0, 0, 0); o[1] = __builtin_amdgcn_mfma_f32_32x32x16_bf16(pa1, C2_VF(l3_, h3_), o[1], 0, 0, 0); \
        C2_VFR(0, 3, l2_, h2_); C2_VFR(1, 3, l3_, h3_); \
        ol = __builtin_amdgcn_mfma_f32_32x32x16_bf16(pa2, ones, ol, 0, 0, 0); o[0] = __builtin_amdgcn_mfma_f32_32x32x16_bf16(pa2, C2_VF(l0_, h0_), o[0], 0, 0, 0); o[1] = __builtin_amdgcn_mfma_f32_32x32x16_bf16(pa2, C2_VF(l1_, h1_), o[1], 0, 0, 0); \
        ol = __builtin_amdgcn_mfma_f32_32x32x16_bf16(pa3, ones, ol, 0, 0, 0); o[0] = __builtin_amdgcn_mfma_f32_32x32x16_bf16(pa3, C2_VF(l2_, h2_), o[0], 0, 0, 0); o[1] = __builtin_amdgcn_mfma_f32_32x32x16_bf16(pa3, C2_VF(l3_, h3_), o[1], 0, 0, 0); } while (0)
  \
#define C2_IMAX2(a, b) ((a) > (b) ? (a) : (b))
#define C2_IMAX3(a, b, c) C2_IMAX2(C2_IMAX2((a), (b)), (c))
#define C2_ROWMAXI(P0, P1, rm_) do { \
        int a_ = C2_IMAX3(__float_as_int(P0[0]), __float_as_int(P0[1]), __float_as_int(P1[0])), b_ = C2_IMAX3(__float_as_int(P0[2]), __float_as_int(P0[3]), __float_as_int(P1[1])); a_ = C2_IMAX3(a_, __float_as_int(P1[2]), __float_as_int(P1[3])); \
        _Pragma("unroll") for (int r = 4; r < 16; r += 4) { a_ = C2_IMAX3(a_, __float_as_int(P0[r]), __float_as_int(P0[r + 1])); b_ = C2_IMAX3(b_, __float_as_int(P0[r + 2]), __float_as_int(P0[r + 3])); \
            a_ = C2_IMAX3(a_, __float_as_int(P1[r]), __float_as_int(P1[r + 1])); b_ = C2_IMAX3(b_, __float_as_int(P1[r + 2]), __float_as_int(P1[r + 3])); } \
        a_ = C2_IMAX2(a_, b_); { auto rr_ = __builtin_amdgcn_permlane32_swap((unsigned)a_, (unsigned)a_, false, false); a_ = C2_IMAX2((int)rr_[0], (int)rr_[1]); } rm_ = __int_as_float(a_); } while (0)
#define C2_ROWMAXF(P0, P1, rm_) do { asm volatile("s_nop 15\n\ts_nop 7" : "+v"(P0), "+v"(P1)); \
        float a_ = max3f(P0[0], P0[1], P1[0]), b_ = max3f(P0[2], P0[3], P1[1]); a_ = max3f(a_, P1[2], P1[3]); \
        _Pragma("unroll") for (int r = 4; r < 16; r += 4) { a_ = max3f(a_, P0[r], P0[r + 1]); b_ = max3f(b_, P0[r + 2], P0[r + 3]); a_ = max3f(a_, P1[r], P1[r + 1]); b_ = max3f(b_, P1[r + 2], P1[r + 3]); } \
        rm_ = max2f(a_, b_); { auto rr_ = __builtin_amdgcn_permlane32_swap(__float_as_uint(rm_), __float_as_uint(rm_), false, false); rm_ = max2f(__uint_as_float(rr_[0]), __uint_as_float(rr_[1])); } } while (0)
#define C2_DECIDE(P0, P1) do { float rm_; C2_ROWMAXI(P0, P1, rm_); if constexpr (!NEGM) rm_ -= mhat; \
        if (__builtin_expect(__any(rm_ > THR2), 0)) { const float dl_ = __builtin_fmaxf(rm_, 0.f); mhat += dl_; \
            if constexpr (NEGM) { _Pragma("unroll") for (int r = 0; r < 16; ++r) { P0[r] -= dl_; P1[r] -= dl_; } \
            _Pragma("unroll") for (int r = 0; r < 16; ++r) negm[r] = -mhat; } \
            const float f_ = __builtin_amdgcn_exp2f(-dl_); if (hi == 0) wsf[r32] = f_; \
            _Pragma("unroll") for (int r = 0; r < 16; ++r) { const float a2_ = wsf[crow(r, hi)]; o[0][r] *= a2_; o[1][r] *= a2_; ol[r] *= a2_; } } } while (0)
    float mhat = 0.f;
    f32x16 negm = f32x16{}, pA0, pA1, pB0, pB1, ol = f32x16{};
    bf16x8 pa0, pa1, pa2, pa3;
    bf16x8 ones = {(short)0x3f80, (short)0x3f80, (short)0x3f80, (short)0x3f80, (short)0x3f80, (short)0x3f80, (short)0x3f80, (short)0x3f80};
    asm volatile("" : "+v"(ones));
    o[0] = f32x16{}; o[1] = f32x16{};
    __syncthreads();
    GLDS_COVER(); C2_DMAK(0, 0); C2_DMAV(0, 0); C2_DMAK(1, 1);
    C2_BAR();
    C2_QKT(pA0, pA1, 0);
    { float rm_; C2_ROWMAXF(pA0, pA1, rm_); mhat = rm_;
      if constexpr (NEGM) {
#pragma unroll
      for (int r = 0; r < 16; ++r) { pA0[r] -= rm_; pA1[r] -= rm_; }
#pragma unroll
      for (int r = 0; r < 16; ++r) negm[r] = -mhat; } }
    const int tl = NT - 1;
    for (int j = 0; j < NT; j += 2) {
        C2_BAR();
        __builtin_amdgcn_iglp_opt(0);
        C2_QKT(pB0, pB1, 1);
        C2_FINISH(pA0, pA1);
        C2_DMAK(j + 2 < NT ? j + 2 : tl, 0); C2_DMAV(j + 1, 1);
        C2_PV(0);
        C2_DECIDE(pB0, pB1);
        C2_BAR();
        __builtin_amdgcn_iglp_opt(0);
        C2_QKT(pA0, pA1, 0);
        C2_FINISH(pB0, pB1);
        C2_DMAK(j + 3 < NT ? j + 3 : tl, 1); C2_DMAV(j + 2 < NT ? j + 2 : tl, 0);
        C2_PV(1);
        C2_DECIDE(pA0, pA1);
    }
    asm volatile("s_waitcnt vmcnt(0)" ::: "memory");
#undef C2_DMAK
#undef C2_DMAV
#undef C2_BAR
#undef C2_QKT
#undef C2_FINISH
#undef C2_VFR
#undef C2_VF
#undef C2_PV
#undef C2_IMAX2
#undef C2_IMAX3
#undef C2_ROWMAXI
#undef C2_ROWMAXF
#undef C2_DECIDE
#pragma unroll
    for (int r = 0; r < 16; ++r) { const float rl = __builtin_amdgcn_rcpf(ol[r]); o[0][r] *= rl; o[1][r] *= rl; }
}
__device__ __forceinline__ void attn_store(const f32x16 (&o)[2], LAS unsigned char* lds, bf16_t* Ow, const int lane, const int wid) {
    const int r32 = lane & 31, hi = lane >> 5;
    LAS bf16_t* stg = (LAS bf16_t*)(lds + AT_OST) + wid * 2048;
#pragma unroll
    for (int r = 0; r < 16; ++r) { const int orow = crow(r, hi);
#pragma unroll
        for (int d0 = 0; d0 < 2; ++d0) stg[orow * 64 + d0 * 32 + r32] = (bf16_t)(cvtpk(o[d0][r], 0.f) & 0xffffu); }
    LDS_WAIT();
#pragma unroll
    for (int i = 0; i < 4; ++i) { const int row = i * 8 + (lane >> 3), ch = lane & 7; const u32x4 v = *(const LAS u32x4*)(stg + row * 64 + ch * 8); *(u32x4*)(Ow + (size_t)row * DM + ch * 8) = v; }
    LDS_WAIT();
}

struct AttnCtx { const bf16_t* U; bf16_t* AO; const float* relb; const float* subln; float lam, lam_init; };
template <int kind>
__device__ __forceinline__ void attn_unit(const AttnCtx& A, LAS unsigned char* lds, int b, int h, int qb, const int wv) {
    const int tid = fresh_tid(wv), wid = __builtin_amdgcn_readfirstlane(tid >> 6), lane = tid & 63, r32 = lane & 31, hi = lane >> 5;
    const size_t seg0 = (size_t)b * SEG;
    const size_t qrow = seg0 + (size_t)qb * 256 + wid * 32 + r32;
    const bf16_t* Uq = A.U + qrow * LDU + hi * 8;
    const bf16_t* Us = A.U + seg0 * LDU;
    int orow0 = b * SEG + qb * 256 + wid * 32;
#define AU_OW() ({ asm volatile("" : "+s"(orow0)); A.AO + (size_t)orow0 * DM; })
    const bool isctx = qb == 32;
    const int td0 = isctx ? 128 : 0, tdn = isctx ? 4 : 132;
    f32x16 o[2];
    if constexpr (kind == 0) {
        for (int mp = 0; mp < 2; ++mp) {
            attn_core2<32>(o, lds, Uq + C_Q + (2 * h + mp) * 32, Us + C_K + (2 * h + mp) * 32, Us, Us + C_V + h * 64, td0, tdn, tid, wid);
            if (mp == 0) { LAS float* o1s = (LAS float*)(lds + AT_O1) + wid * 2048 + lane_fresh();
#pragma unroll
                for (int r = 0; r < 16; ++r) { o1s[r * 64] = o[0][r]; o1s[(16 + r) * 64] = o[1][r]; } }
        }
        f32x16 o1[2];
        { const LAS float* o1s = (const LAS float*)(lds + AT_O1) + wid * 2048 + lane_fresh();
#pragma unroll
          for (int r = 0; r < 16; ++r) { o1[0][r] = o1s[r * 64]; o1[1][r] = o1s[(16 + r) * 64]; } }
        const float g0 = A.subln[r32] * (1.f - A.lam_init), g1 = A.subln[32 + r32] * (1.f - A.lam_init);
#pragma unroll
        for (int r = 0; r < 16; ++r) {
            const float d0 = o1[0][r] - A.lam * o[0][r], d1 = o1[1][r] - A.lam * o[1][r];
            float ss = d0 * d0 + d1 * d1;
#pragma unroll
            for (int s = 1; s < 32; s <<= 1) ss += __shfl_xor(ss, s);
            const float rs = __builtin_amdgcn_rsqf(ss * (1.f / 64.f) + EPS);
            o[0][r] = d0 * rs * g0; o[1][r] = d1 * rs * g1;
        }
        attn_store(o, lds, AU_OW() + 512 + h * 64, lane, wid);
    } else if constexpr (kind == 1) {
        attn_core2<96>(o, lds, Uq + D_Q + h * 96, Us + D_KN + h * 64, Us + D_KPE, Us + D_V + h * 64, td0, tdn, tid, wid);
        attn_store(o, lds, AU_OW() + 768 + h * 64, lane, wid);
    } else if constexpr (kind == 2) {
        attn_core2<64>(o, lds, Uq + A_Q + h * 64, Us + A_K + (h >> 1) * 64, Us, Us + A_V + (h >> 1) * 64, td0, tdn, tid, wid);
        attn_store(o, lds, AU_OW() + h * 64, lane, wid);
    } else {
        if (isctx) {
            attn_core2<64, false>(o, lds, Uq + B_Q + h * 64, Us + B_K + h * 64, Us, Us + B_V + h * 64, 128, 4, tid, wid);
        } else {
            { LAS float* bt = (LAS float*)(lds + AT_BT); if (tid < 465) bt[tid] = A.relb[h * 465 + tid] * LOG2E; }
            const int ra = 4 * qb - 4 < 0 ? 0 : (4 * qb - 4 > 120 ? 120 : 4 * qb - 4);
            const int rb_ = 4 * qb - 1 < 0 ? 0 : (4 * qb - 1 > 120 ? 120 : 4 * qb - 1);
            attn_core_na(o, lds, Uq + B_Q + h * 64, Us + B_K + h * 64, Us + B_V + h * 64, ra, rb_ + 8 - ra, 4 * qb + (wid >> 1), tid, wid);
        }
        attn_store(o, lds, AU_OW() + 256 + h * 64, lane, wid);
    }
#undef AU_OW
}
template <int kind>
__device__ __forceinline__ void attn_kind_loop(const AttnCtx& A, LAS unsigned char* lds, unsigned* qheads  , int nq, unsigned xcc, const int wv) {
    const int QN = 2 * nq;
    int qoff = 0;
    unsigned pre = 0xffffffffu;
    for (;;) {
        unsigned pop_a = (unsigned)(uintptr_t)(lds + MISC_POP); asm volatile("" : "+v"(pop_a));
        volatile LAS int* pop = (volatile LAS int*)pop_a;
        if (is_t0(wv)) {
            int res = -1;
            if (kind < 3 && pre != 0xffffffffu) {
                if (pre < (unsigned)QN) res = (int)((xcc + qoff) & 7u) * 65536 + (int)pre; else ++qoff;
            }
            if (res < 0) {
                while (qoff < 8) {
                    const int q = (int)((xcc + qoff) & 7u);
                    const unsigned idx = xb_add(qheads + 64 * q, 1u);
                    if (idx < (unsigned)QN) { res = q * 65536 + (int)idx; break; }
                    ++qoff;
                }
            }
            pop[0] = res;
        }
        __syncthreads();
        const int res = __builtin_amdgcn_readfirstlane(pop[0]);
        __syncthreads();
        if (res < 0) break;
        if (kind < 3) { pre = 0xffffffffu; if (is_t0(wv) && qoff < 8) pre = xb_add(qheads + 64 * (int)((xcc + qoff) & 7u), 1u); }
        const int q = res >> 16, idx = res & 0xffff, gi = idx / nq, qb = idx - gi * nq, gk = gi * 8 + q;
        attn_unit<kind>(A, lds, gk >> 2, gk & 3, qb, wv);
    }
}
__device__ __forceinline__ void attn_phase(const AttnCtx& A, LAS unsigned char* lds, unsigned* qheads  , int nq, unsigned xcc, const int wv) {
    attn_kind_loop<0>(A, lds, qheads + 0 * 8 * 64, nq, xcc, wv);
    attn_kind_loop<1>(A, lds, qheads + 1 * 8 * 64, nq, xcc, wv);
    attn_kind_loop<2>(A, lds, qheads + 2 * 8 * 64, nq, xcc, wv);
    attn_kind_loop<3>(A, lds, qheads + 3 * 8 * 64, nq, xcc, wv);
}

__device__ __forceinline__ void transpose_item(const float* W, int K, int N, bf16_t* WT, int drow0, LAS float* scr, int kb, int nb, int lane) {
    const int k0 = 64 * kb, n0 = 32 * nb;
    float tv[32];
#pragma unroll
    for (int i = 0; i < 32; ++i) { const int kk = 2 * i + (lane >> 5); tv[i] = W[(size_t)(k0 + kk) * N + n0 + (lane & 31)]; }
#pragma unroll
    for (int i = 0; i < 32; ++i) { const int kk = 2 * i + (lane >> 5); scr[kk * 33 + (lane & 31)] = tv[i]; }
    LDS_WAIT(); asm volatile("" ::: "memory");
    const int c = lane & 7;
#pragma unroll
    for (int j = 0; j < 4; ++j) { const int n = (lane >> 3) + 8 * j; const LAS float* s = scr + (8 * c) * 33 + n;
        u32x4 o; o.x = cvtpk(s[0 * 33], s[1 * 33]); o.y = cvtpk(s[2 * 33], s[3 * 33]); o.z = cvtpk(s[4 * 33], s[5 * 33]); o.w = cvtpk(s[6 * 33], s[7 * 33]);
        *(u32x4*)(WT + (size_t)(drow0 + n) * K + k0 + 8 * c) = o; }
    LDS_WAIT(); asm volatile("" ::: "memory");
}
__device__ __forceinline__ void prologue(KA a, LAS unsigned char* lds, int G, const int wv) {
    const int tid = fresh_tid(wv), wid = __builtin_amdgcn_readfirstlane(tid >> 6), lane = tid & 63, blk = blockIdx.x;
    unsigned char* ws = a->ws;
    float* MOD = (float*)(ws + WS_MOD);
    bf16_t* WINT = (bf16_t*)(ws + WS_WINT);
#define PRO_PART3() do { \
    { \
        LAS float* scr = (LAS float*)(lds + 16384 + wid * 8704); \
        const int gw = blk * 8 + wid, NGW = G * 8; \
        constexpr int I_IN = 16 * 75, I_OUT = 16 * 32, I_GU = 17 * 2 * 16 * 8, I_DN = 17 * 4 * 32, I_L = I_IN + I_OUT + I_GU + I_DN; \
        bf16_t* WOUTT = (bf16_t*)(ws + WS_WOUTT); bf16_t* WGU = (bf16_t*)(ws + WS_WGU); bf16_t* WDN = (bf16_t*)(ws + WS_WDN); \
        for (int it = gw; it < 2 * I_L; it += NGW) { \
            const int l = it / I_L; int r = it - l * I_L; \
            if (r < I_IN) { transpose_item(a->w_in + (size_t)l * 1024 * INCOLS, 1024, INCOLS, WINT + (size_t)l * LDU * 1024, 32 * (r % 75), scr, r / 75, r % 75, lane); continue; } r -= I_IN; \
            if (r < I_OUT) { transpose_item(a->w_out + (size_t)l * 1024 * 1024, 1024, 1024, WOUTT + (size_t)l * 1024 * 1024, 32 * (r % 32), scr, r / 32, r % 32, lane); continue; } r -= I_OUT; \
            if (r < I_GU) { const int e = r / 256, r2 = r % 256, up = r2 >> 7, r3 = r2 & 127, kb = r3 >> 3, nb = r3 & 7; \
                const float* src = e < 16 ? (up ? a->wu : a->wg) + ((size_t)l * 16 + e) * 1024 * 256 : (up ? a->su : a->sg) + (size_t)l * 1024 * 256; \
                const int n0 = 32 * nb; transpose_item(src, 1024, 256, WGU + ((size_t)l * 17 + e) * 512 * 1024, 256 * (n0 >> 7) + 128 * up + (n0 & 127), scr, kb, nb, lane); continue; } r -= I_GU; \
            { const int e = r / 128, r2 = r % 128, kb = r2 >> 5, nb = r2 & 31; \
                const float* src = e < 16 ? a->wd + ((size_t)l * 16 + e) * 256 * 1024 : a->sd + (size_t)l * 256 * 1024; \
                transpose_item(src, 256, 1024, WDN + ((size_t)l * 17 + e) * 1024 * 256, 32 * nb, scr, kb, nb, lane); } \
        } \
    } \
    } while (0)
    if (blk & 1) { PRO_PART3(); __syncthreads(); }
    {
        LAS float* sil = (LAS float*)lds;
        LAS float* part = (LAS float*)(lds + 20480);
        for (int i = tid; i < 5 * 1024; i += 512) { const int r = i >> 10, k = i & 1023; const float v = r < 4 ? a->c[r * 1024 + k] : a->c_ctx[k]; sil[i] = v / (1.f + __expf(-v)); }
        __syncthreads();
        for (int it = blk; it < 2 * 96; it += G) {
            const int l = it / 96, n0 = (it % 96) * 64;
            const float* wm = a->w_mod + (size_t)l * 1024 * 6144 + n0 + lane;
            float acc[5] = {0.f, 0.f, 0.f, 0.f, 0.f};
#pragma unroll 4
            for (int k = wid * 128; k < wid * 128 + 128; k += 4) {
                const float w0 = wm[(size_t)k * 6144], w1 = wm[(size_t)(k + 1) * 6144], w2 = wm[(size_t)(k + 2) * 6144], w3 = wm[(size_t)(k + 3) * 6144];
#pragma unroll
                for (int r = 0; r < 5; ++r) { const f32x4 s4 = *(const LAS f32x4*)(sil + r * 1024 + k); acc[r] += (s4.x * w0 + s4.y * w1) + (s4.z * w2 + s4.w * w3); } }
#pragma unroll
            for (int r = 0; r < 5; ++r) part[(wid * 5 + r) * 64 + lane] = acc[r];
            __syncthreads();
            if (tid < 320) { const int r = tid >> 6, n = tid & 63; float s = a->b_mod[l * 6144 + n0 + n];
#pragma unroll
                for (int w = 0; w < 8; ++w) s += part[(w * 5 + r) * 64 + n];
                MOD[((size_t)l * 5 + r) * 6144 + n0 + n] = s; }
            __syncthreads();
        }
        if (blk == 0 && tid < 2) {
            const int l = tid; float s1 = 0.f, s2 = 0.f;
            for (int i = 0; i < 32; ++i) { s1 += a->lq1[l * 32 + i] * a->lk1[l * 32 + i]; s2 += a->lq2[l * 32 + i] * a->lk2[l * 32 + i]; }
            const float lam_init = 0.8f - 0.6f * expf(-0.3f * (float)l);
            ((float*)(ws + WS_LAM))[l] = expf(s1) - expf(s2) + lam_init;
        }
        __syncthreads();
    }
    {
        LAS float* aw = (LAS float*)lds;
        for (int it = blk; it < 2 * 128; it += G) {
            const int l = it >> 7, k0 = (it & 127) * 8;
            for (int i = tid; i < 8 * 320; i += 512) { const int kk = i / 320, j = i - kk * 320;
                const float g = j < 192 ? a->mla_qn[l * 192 + j] : a->mla_kvn[l * 128 + (j - 192)];
                aw[i] = a->w_in[((size_t)l * 1024 + k0 + kk) * INCOLS + D_CQ + j] * g; }
            __syncthreads();
            for (int n = tid; n < 896; n += 512) {
                float acc[8] = {0.f, 0.f, 0.f, 0.f, 0.f, 0.f, 0.f, 0.f};
                int drow;
                if (n < 384) {
                    const float* wq = a->mla_wqu + (size_t)l * 192 * 384 + n;
#pragma unroll 4
                    for (int j = 0; j < 192; j += 4) { const float w0 = wq[(size_t)j * 384], w1 = wq[(size_t)(j + 1) * 384], w2 = wq[(size_t)(j + 2) * 384], w3 = wq[(size_t)(j + 3) * 384];
#pragma unroll
                        for (int kk = 0; kk < 8; ++kk) { const f32x4 a4 = *(const LAS f32x4*)(aw + kk * 320 + j); acc[kk] += (a4.x * w0 + a4.y * w1) + (a4.z * w2 + a4.w * w3); } }
                    drow = D_Q + n;
                } else {
                    const int n2 = n - 384; const float* wk = a->mla_wkvu + (size_t)l * 128 * 512 + n2;
#pragma unroll 4
                    for (int j = 0; j < 128; j += 4) { const float w0 = wk[(size_t)j * 512], w1 = wk[(size_t)(j + 1) * 512], w2 = wk[(size_t)(j + 2) * 512], w3 = wk[(size_t)(j + 3) * 512];
#pragma unroll
                        for (int kk = 0; kk < 8; ++kk) { const f32x4 a4 = *(const LAS f32x4*)(aw + kk * 320 + 192 + j); acc[kk] += (a4.x * w0 + a4.y * w1) + (a4.z * w2 + a4.w * w3); } }
                    const int hh = n2 >> 7, cc = n2 & 127;
                    drow = cc < 64 ? D_KN + hh * 64 + cc : D_V + hh * 64 + (cc - 64);
                }
                u32x4 w; w.x = cvtpk(acc[0], acc[1]); w.y = cvtpk(acc[2], acc[3]); w.z = cvtpk(acc[4], acc[5]); w.w = cvtpk(acc[6], acc[7]);
                *(u32x4*)(WINT + ((size_t)l * LDU + drow) * 1024 + k0) = w;
            }
            __syncthreads();
        }
        for (int i = blk * 512 + tid; i < 2 * 32 * 128; i += G * 512) { const int l = i / 4096, r = (i % 4096) / 128, ch = i % 128;
            *(u32x4*)(WINT + ((size_t)l * LDU + U_PAD0 + r) * 1024 + ch * 8) = (u32x4){0u, 0u, 0u, 0u}; }
    }
    if (!(blk & 1)) { __syncthreads(); PRO_PART3(); }
#undef PRO_PART3
}

__device__ __forceinline__ void load_row16(const float* row, int lane, f32x4 (&v)[4]) {
#pragma unroll
    for (int j = 0; j < 4; ++j) v[j] = *(const f32x4*)(row + 4 * lane + 256 * j);
}
__device__ __forceinline__ void load_row16_bf(const bf16_t* row, int lane, f32x4 (&v)[4]) {
#pragma unroll
    for (int j = 0; j < 4; ++j) { const u32x2 w = *(const u32x2*)(row + 4 * lane + 256 * j); v[j] = (f32x4){bf_lo(w.x), bf_hi(w.x), bf_lo(w.y), bf_hi(w.y)}; }
}
__device__ __forceinline__ void store_row16_bf(bf16_t* row, int lane, const f32x4 (&v)[4]) {
#pragma unroll
    for (int j = 0; j < 4; ++j) { u32x2 w; w.x = cvtpk(v[j].x, v[j].y); w.y = cvtpk(v[j].z, v[j].w); *(u32x2*)(row + 4 * lane + 256 * j) = w; }
}
__device__ __forceinline__ float sumsq16(const f32x4 (&v)[4]) {
    float s = 0.f;
#pragma unroll
    for (int j = 0; j < 4; ++j) s += (v[j].x * v[j].x + v[j].y * v[j].y) + (v[j].z * v[j].z + v[j].w * v[j].w);
    return s;
}
struct ModCoef { f32x4 ga[4], gb[4]; int cls; };
__device__ __forceinline__ void modcoef_load(ModCoef& mc, const float* norm, const float* modl  , int cls, int shift_off, int lane) {
    mc.cls = cls;
#pragma unroll
    for (int j = 0; j < 4; ++j) { const int c = 4 * lane + 256 * j; const f32x4 g = *(const f32x4*)(norm + c), sh = *(const f32x4*)(modl + cls * 6144 + shift_off + c), sc = *(const f32x4*)(modl + cls * 6144 + shift_off + 1024 + c);
        mc.ga[j] = g * (sc + 1.f); mc.gb[j] = sh; }
}
__device__ __forceinline__ void store_h16(bf16_t* hrow, int lane, const f32x4 (&v)[4], float rstd, const ModCoef& mc) {
#pragma unroll
    for (int j = 0; j < 4; ++j) { const f32x4 y = v[j] * rstd * mc.ga[j] + mc.gb[j]; u32x2 w; w.x = cvtpk(y.x, y.y); w.y = cvtpk(y.z, y.w); *(u32x2*)(hrow + 4 * lane + 256 * j) = w; }
}
__device__ __forceinline__ void wave_rows(int ch, int wid, int& rbeg, int& nrow) { rbeg = ch * 132 + wid * 16 + (wid < 4 ? wid : 4); nrow = 16 + (wid < 4 ? 1 : 0); }
__device__ __forceinline__ void phase_norm1(KA a, int G, const int wv) {
    const int tid = fresh_tid(wv), wid = __builtin_amdgcn_readfirstlane(tid >> 6), lane = tid & 63;
    const float* modl = (const float*)(a->ws + WS_MOD); bf16_t* H = (bf16_t*)(a->ws + WS_H);
    const float* XL = a->x; const float* XC = a->ctx;
    ModCoef mc; mc.cls = -1;
    for (int ch = blockIdx.x; ch < 256; ch += G) {
        int rbeg, nrow; wave_rows(ch, wid, rbeg, nrow);
        f32x4 vn[2][4];
        load_row16(xrow_in(XL, XC, rbeg), lane, vn[0]); load_row16(xrow_in(XL, XC, rbeg + 1), lane, vn[1]);
        for (int i = 0; i < nrow; i += 2) {
            f32x4 v[2][4];
#pragma unroll
            for (int k = 0; k < 2; ++k)
#pragma unroll
                for (int j = 0; j < 4; ++j) v[k][j] = vn[k][j];
            if (i + 2 < nrow) { load_row16(xrow_in(XL, XC, rbeg + i + 2), lane, vn[0]); load_row16(xrow_in(XL, XC, rbeg + (i + 3 < nrow ? i + 3 : nrow - 1)), lane, vn[1]); }
#pragma unroll
            for (int k = 0; k < 2; ++k) if (i + k < nrow) {
                const int R = rbeg + i + k, b = R / SEG, t = R - b * SEG, cls = t < SEQ ? b : 4;
                if (cls != mc.cls) modcoef_load(mc, a->norm_mix, modl, cls, 0, lane);
                const float rstd = __builtin_amdgcn_rsqf(wave_sum(sumsq16(v[k])) * (1.f / 1024.f) + EPS);
                store_h16(H + (size_t)R * DM, lane, v[k], rstd, mc);
            }
        }
    }
}

template <bool DRY = false>
__device__ __forceinline__ void phase_post(KA a, LAS unsigned char* lds, int l, int G, const int wv) {
    const int tid = fresh_tid(wv), wid = __builtin_amdgcn_readfirstlane(tid >> 6), lane = tid & 63;
    LAS f32x2* T64 = (LAS f32x2*)lds;
    LAS f32x2* T32 = (LAS f32x2*)(lds + 16384);
    for (int i = tid; i < 2048; i += 512) { const int pos = i >> 4, k = i & 15; const float ang = (float)pos * powf(10000.f, -(float)k / 16.f); float s, c; sincosf(ang, &s, &c); T64[i] = (f32x2){c, s}; }
    for (int i = tid; i < 1024; i += 512) { const int pos = i >> 3, k = i & 7; const float ang = (float)pos * powf(10000.f, -(float)k / 8.f); float s, c; sincosf(ang, &s, &c); T32[i] = (f32x2){c, s}; }
    __syncthreads();
    bf16_t* U = (bf16_t*)(a->ws + WS_U);
    const float* qg = a->gqa_qn + l * 64; const float* kg = a->gqa_kn + l * 64;
    const int j16 = lane & 15;
    f32x4 gq, gk; { const int d = 4 * j16; gq = *(const f32x4*)(qg + d) * QS64; gk = *(const f32x4*)(kg + d); }
    struct PostIn { u32x2 wq, wk, cq, ck; unsigned w0, w1, w2, dq[4], kpe; u32x4 kn; };
#define POST_LOAD(in_, R_) do { const bf16_t* u_ = U + (size_t)(R_) * LDU; \
        in_.wq = *(const u32x2*)(u_ + A_Q + 4 * lane); in_.wk = *(const u32x2*)(u_ + A_K + 4 * (lane & 31)); \
        in_.cq = *(const u32x2*)(u_ + C_Q + 4 * lane); in_.ck = *(const u32x2*)(u_ + C_K + 4 * lane); \
        in_.w0 = *(const unsigned*)(u_ + D_CQ + 2 * lane); in_.w1 = *(const unsigned*)(u_ + D_CQ + 128 + 2 * (lane & 31)); in_.w2 = *(const unsigned*)(u_ + D_CKV + 2 * lane); \
        _Pragma("unroll") for (int hh_ = 0; hh_ < 4; ++hh_) in_.dq[hh_] = *(const unsigned*)(u_ + D_Q + hh_ * 96 + 2 * lane); \
        in_.kpe = *(const unsigned*)(u_ + D_KPE + 2 * (lane & 15)); in_.kn = *(const u32x4*)(u_ + D_KN + 8 * lane); } while (0)
    for (int ch = blockIdx.x; ch < 256; ch += G) {
        PostIn nx; POST_LOAD(nx, ch * 132 + wid);
        for (int rr = wid; rr < 132; rr += 8) {
            const int R = ch * 132 + rr, b = R / SEG, t = R - b * SEG; const bool lat = t < SEQ; const int gr = t >> 6, gc = t & 63;
            bf16_t* u = U + (size_t)R * LDU;
            const ptrdiff_t dso = DRY ? ((char*)((bf16_t*)(a->ws + WS_DRY) + (size_t)(R & 1023) * LDU) - (char*)u) : 0;
            const PostIn in = nx;
            if (rr + 8 < 132) POST_LOAD(nx, R + 8);
            {
                const u32x2 wq = in.wq; const u32x2 wk = in.wk;
                f32x4 xq = {bf_lo(wq.x), bf_hi(wq.x), bf_lo(wq.y), bf_hi(wq.y)}, xk = {bf_lo(wk.x), bf_hi(wk.x), bf_lo(wk.y), bf_hi(wk.y)};
                float sq = (xq.x * xq.x + xq.y * xq.y) + (xq.z * xq.z + xq.w * xq.w), sk = (xk.x * xk.x + xk.y * xk.y) + (xk.z * xk.z + xk.w * xk.w);
                sq = row16_sum(sq); sk = row16_sum(sk);
                xq = xq * __builtin_amdgcn_rsqf(sq * (1.f / 64.f) + EPS) * gq; xk = xk * __builtin_amdgcn_rsqf(sk * (1.f / 64.f) + EPS) * gk;
                f32x4 pq, pk;
#pragma unroll
                for (int e = 0; e < 4; ++e) { pq[e] = lane_xor4(xq[e]); pk[e] = lane_xor4(xk[e]); }
                if (lat) {
                    const int jj = j16 & 7, pos = (j16 >> 3) ? gc : gr; const bool x2 = jj >= 4; const int i0 = 4 * (jj & 3);
#pragma unroll
                    for (int e = 0; e < 4; ++e) { const f32x2 cs = T64[pos * 16 + i0 + e];
                        xq[e] = x2 ? pq[e] * cs.y + xq[e] * cs.x : xq[e] * cs.x - pq[e] * cs.y;
                        xk[e] = x2 ? pk[e] * cs.y + xk[e] * cs.x : xk[e] * cs.x - pk[e] * cs.y; }
                }
                u32x2 o; o.x = cvtpk(xq.x, xq.y); o.y = cvtpk(xq.z, xq.w); *(u32x2*)((char*)(u + A_Q + 4 * lane) + dso) = o;
                if (lane < 32) { o.x = cvtpk(xk.x, xk.y); o.y = cvtpk(xk.z, xk.w); *(u32x2*)((char*)(u + A_K + 4 * lane) + dso) = o; }
            }
            if (lat) {
                const int jj = lane & 7, pos = (jj >> 2) ? gc : gr; const bool x2 = (jj >> 1) & 1; const int i0 = 4 * (jj & 1);
#pragma unroll
                for (int qk = 0; qk < 2; ++qk) {
                    bf16_t* p = u + (qk ? C_K : C_Q) + 4 * lane;
                    const u32x2 w = qk ? in.ck : in.cq; f32x4 x = {bf_lo(w.x), bf_hi(w.x), bf_lo(w.y), bf_hi(w.y)}, pp;
#pragma unroll
                    for (int e = 0; e < 4; ++e) pp[e] = lane_xor2(x[e]);
#pragma unroll
                    for (int e = 0; e < 4; ++e) { const f32x2 cs = T32[pos * 8 + i0 + e]; x[e] = x2 ? pp[e] * cs.y + x[e] * cs.x : x[e] * cs.x - pp[e] * cs.y; }
                    u32x2 o; o.x = cvtpk(x.x, x.y); o.y = cvtpk(x.z, x.w); *(u32x2*)((char*)p + dso) = o;
                }
            }
            {
                const unsigned w0 = in.w0, w1 = in.w1, w2 = in.w2;
                float sq = bf_lo(w0) * bf_lo(w0) + bf_hi(w0) * bf_hi(w0); if (lane < 32) sq += bf_lo(w1) * bf_lo(w1) + bf_hi(w1) * bf_hi(w1);
                float sk = bf_lo(w2) * bf_lo(w2) + bf_hi(w2) * bf_hi(w2);
                const float rq = __builtin_amdgcn_rsqf(wave_sum(sq) * (1.f / 192.f) + EPS), rk = __builtin_amdgcn_rsqf(wave_sum(sk) * (1.f / 128.f) + EPS);
                const int lp = lane & 15, pj = lp >> 2; const bool px2 = pj & 1; const int ppos = (pj >> 1) ? gc : gr, pi0 = 2 * (lp & 3);
#pragma unroll
                for (int hh = 0; hh < 4; ++hh) {
                    bf16_t* p = u + D_Q + hh * 96 + 2 * lane;
                    const unsigned w = in.dq[hh]; float x0 = bf_lo(w) * (rq * QS96), x1 = bf_hi(w) * (rq * QS96);
                    const float y0 = lane_xor4(x0), y1 = lane_xor4(x1);
                    if (lat && lane >= 32) { const f32x2 c0 = T32[ppos * 8 + pi0], c1 = T32[ppos * 8 + pi0 + 1];
                        x0 = px2 ? y0 * c0.y + x0 * c0.x : x0 * c0.x - y0 * c0.y; x1 = px2 ? y1 * c1.y + x1 * c1.x : x1 * c1.x - y1 * c1.y; }
                    if (lane < 48) *(unsigned*)((char*)p + dso) = cvtpk(x0, x1);
                }
                {
                    bf16_t* p = u + D_KPE + 2 * (lane & 15);
                    const unsigned w = in.kpe; float x0 = bf_lo(w), x1 = bf_hi(w);
                    const float y0 = lane_xor4(x0), y1 = lane_xor4(x1);
                    if (lat) { const f32x2 c0 = T32[ppos * 8 + pi0], c1 = T32[ppos * 8 + pi0 + 1];
                        x0 = px2 ? y0 * c0.y + x0 * c0.x : x0 * c0.x - y0 * c0.y; x1 = px2 ? y1 * c1.y + x1 * c1.x : x1 * c1.x - y1 * c1.y; }
                    if (lat && lane < 16) *(unsigned*)((char*)p + dso) = cvtpk(x0, x1);
                }
                {
                    bf16_t* p = u + D_KN + 8 * lane; const u32x4 w = in.kn; u32x4 o;
                    o.x = cvtpk(bf_lo(w.x) * rk, bf_hi(w.x) * rk); o.y = cvtpk(bf_lo(w.y) * rk, bf_hi(w.y) * rk); o.z = cvtpk(bf_lo(w.z) * rk, bf_hi(w.z) * rk); o.w = cvtpk(bf_lo(w.w) * rk, bf_hi(w.w) * rk);
                    *(u32x4*)((char*)p + dso) = o;
                }
            }
        }
    }
#undef POST_LOAD
}

template <bool DRY = false>
__device__ __forceinline__ void phase_route(KA a, LAS unsigned char* lds, int l, int G, const int wv) {
    const int tid = fresh_tid(wv), wid = __builtin_amdgcn_readfirstlane(tid >> 6), lane = tid & 63;
    unsigned char* ws = a->ws;
    const float* modl = (const float*)(ws + WS_MOD) + (size_t)l * 5 * 6144; bf16_t* H = (bf16_t*)(ws + WS_H);
    const bf16_t* X1 = (const bf16_t*)(ws + WS_X1);
    unsigned* ecnt = (unsigned*)(ws + WS_CTL) + CW_ECNT + l * 16 * 64;
    unsigned* LIST = (unsigned*)(ws + WS_LIST); float* WL = (float*)(ws + WS_WL); unsigned* RSLOT = (unsigned*)(ws + WS_RSLOT);
    LAS float* rwT = (LAS float*)lds;
    LAS unsigned* RE = (LAS unsigned*)(lds + 65536);
    LAS float* RW0 = (LAS float*)(lds + 65536 + 1024);
    LAS float* RW1 = (LAS float*)(lds + 65536 + 2048);
    for (int i = tid; i < 16384; i += 512) { const int k = i >> 4, e = i & 15; rwT[e * 1024 + k] = a->router_w[i]; }
    __syncthreads();
    const float rbl = a->router_b[lane >> 2];
    ModCoef mc; mc.cls = -1;
    const bool b5 = lane & 32, b4 = lane & 16, b3 = lane & 8, b2 = lane & 4;
    for (int ch = blockIdx.x; ch < 256; ch += G) {
        int rbeg, nrow; wave_rows(ch, wid, rbeg, nrow);
        f32x4 vn[4];
        load_row16_bf(X1 + (size_t)rbeg * DM, lane, vn);
        for (int i = 0; i < nrow; ++i) {
            f32x4 v[4];
#pragma unroll
            for (int j = 0; j < 4; ++j) v[j] = vn[j];
            if (i + 1 < nrow) load_row16_bf(X1 + (size_t)(rbeg + i + 1) * DM, lane, vn);
            const int R = rbeg + i, rr = R - ch * 132, b = R / SEG, t = R - b * SEG, cls = t < SEQ ? b : 4;
            if (l == 1 && cls == 4) { if (lane == 0) RE[rr] = 0xffffu; continue; }
            if (cls != mc.cls) modcoef_load(mc, a->norm_ffn + l * 1024, modl, cls, 3072, lane);
            const float rstd = __builtin_amdgcn_rsqf(wave_sum(sumsq16(v)) * (1.f / 1024.f) + EPS);
            f32x4 hv[4];
#pragma unroll
            for (int j = 0; j < 4; ++j) hv[j] = v[j] * rstd * mc.ga[j] + mc.gb[j];
            { bf16_t* hrow = DRY ? (bf16_t*)(ws + WS_DRY) + (size_t)(R & 1023) * DM : H + (size_t)R * DM;
#pragma unroll
              for (int j = 0; j < 4; ++j) { u32x2 w; w.x = cvtpk(hv[j].x, hv[j].y); w.y = cvtpk(hv[j].z, hv[j].w); *(u32x2*)(hrow + 4 * lane + 256 * j) = w; } }
            float s16[16];
            f32x4 wb[2][2][4];
#pragma unroll
            for (int q = 0; q < 2; ++q)
#pragma unroll
                for (int j = 0; j < 4; ++j) wb[0][q][j] = *(const LAS f32x4*)(rwT + q * 1024 + 4 * lane + 256 * j);
#pragma unroll
            for (int e2 = 0; e2 < 16; e2 += 2) {
                const int cb = (e2 >> 1) & 1;
                if (e2 + 2 < 16) {
#pragma unroll
                    for (int q = 0; q < 2; ++q)
#pragma unroll
                        for (int j = 0; j < 4; ++j) wb[cb ^ 1][q][j] = *(const LAS f32x4*)(rwT + (e2 + 2 + q) * 1024 + 4 * lane + 256 * j); }
                __builtin_amdgcn_sched_barrier(0);
                { f32x2 ac[2][2] = {{{0.f, 0.f}, {0.f, 0.f}}, {{0.f, 0.f}, {0.f, 0.f}}};
#pragma unroll
                  for (int j = 0; j < 4; ++j)
#pragma unroll
                      for (int q = 0; q < 2; ++q) { const f32x4 w = wb[cb][q][j]; ac[q][0] = (f32x2){hv[j].x, hv[j].y} * (f32x2){w.x, w.y} + ac[q][0]; ac[q][1] = (f32x2){hv[j].z, hv[j].w} * (f32x2){w.z, w.w} + ac[q][1]; }
#pragma unroll
                  for (int q = 0; q < 2; ++q) { const f32x2 t = ac[q][0] + ac[q][1]; s16[e2 + q] = t.x + t.y; } }
                __builtin_amdgcn_sched_barrier(0); }
            float s8[8], s4[4], s2[2], s1;
#pragma unroll
            for (int e = 0; e < 8; ++e) { auto p = __builtin_amdgcn_permlane32_swap(__float_as_uint(s16[e]), __float_as_uint(s16[8 + e]), false, false); s8[e] = __uint_as_float(p[0]) + __uint_as_float(p[1]); }
#pragma unroll
            for (int e = 0; e < 4; ++e) { auto p = __builtin_amdgcn_permlane16_swap(__float_as_uint(s8[e]), __float_as_uint(s8[4 + e]), false, false); s4[e] = __uint_as_float(p[0]) + __uint_as_float(p[1]); }
#pragma unroll
            for (int e = 0; e < 2; ++e) { const float keep = b3 ? s4[2 + e] : s4[e], send = b3 ? s4[e] : s4[2 + e];
                s2[e] = keep + __int_as_float(__builtin_amdgcn_update_dpp(0, __float_as_int(send), 0x128, 0xf, 0xf, true)); }
            { const float keep = b2 ? s2[1] : s2[0], send = b2 ? s2[0] : s2[1];
              s1 = keep + lane_xor4(send); }
            s1 += __int_as_float(__builtin_amdgcn_update_dpp(0, __float_as_int(s1), 0x4E, 0xf, 0xf, true));
            s1 += __int_as_float(__builtin_amdgcn_update_dpp(0, __float_as_int(s1), 0xB1, 0xf, 0xf, true));
            const float sig = 1.f / (1.f + __expf(-s1));
            const float sv = sig + rbl;
            float m1 = __builtin_fmaxf(sv, DPPF(sv, 0x141)); m1 = __builtin_fmaxf(m1, DPPF(m1, 0x140));
            const unsigned long long bm1 = __ballot(sv == m1);
            const int f1 = __builtin_ctz((unsigned)(bm1 >> (lane & 48)) & 0xffffu) >> 2;
            const float sv2 = ((lane & 15) >> 2) == f1 ? -1e30f : sv;
            float m2 = __builtin_fmaxf(sv2, DPPF(sv2, 0x141)); m2 = __builtin_fmaxf(m2, DPPF(m2, 0x140));
            const unsigned long long bm2 = __ballot(sv2 == m2);
            const int f2 = __builtin_ctz((unsigned)(bm2 >> (lane & 48)) & 0xffffu) >> 2;
            const float gsum = m1 + m2;
            const float g0 = __uint_as_float(__builtin_amdgcn_readlane(__float_as_uint(gsum), 0)), g1 = __uint_as_float(__builtin_amdgcn_readlane(__float_as_uint(gsum), 16)),
                        g2 = __uint_as_float(__builtin_amdgcn_readlane(__float_as_uint(gsum), 32)), g3 = __uint_as_float(__builtin_amdgcn_readlane(__float_as_uint(gsum), 48));
            int bg = 0; float bgs = g0; if (g1 > bgs) { bgs = g1; bg = 1; } if (g2 > bgs) { bgs = g2; bg = 2; } if (g3 > bgs) { bgs = g3; bg = 3; }
            const int bl = __builtin_amdgcn_readfirstlane(bg) * 16;
            const int e0 = (bl >> 2) + __builtin_amdgcn_readlane(f1, bl), e1 = (bl >> 2) + __builtin_amdgcn_readlane(f2, bl);
            const float w0 = __uint_as_float(__builtin_amdgcn_readlane(__float_as_uint(sig), 4 * e0)), w1 = __uint_as_float(__builtin_amdgcn_readlane(__float_as_uint(sig), 4 * e1));
            const float inv = 1.f / (w0 + w1);
            if (lane == 0) { RE[rr] = (unsigned)e0 | ((unsigned)e1 << 8); RW0[rr] = w0 * inv; RW1[rr] = w1 * inv; }
        }
        __syncthreads();
        if (!DRY) {
            LAS unsigned* CNT = (LAS unsigned*)(lds + 65536 + 3072);
            LAS unsigned* BAS = (LAS unsigned*)(lds + 65536 + 3136);
            if (tid < 16) CNT[tid] = 0u;
            __syncthreads();
            unsigned e_me = 0xffu, li = 0u; int rr_me = 0, sl_me = 0;
            if (tid < 264) { rr_me = tid >> 1; sl_me = tid & 1; const unsigned re = RE[rr_me];
                if (re != 0xffffu) { e_me = sl_me ? (re >> 8) : (re & 0xffu); li = __hip_atomic_fetch_add(CNT + e_me, 1u, __ATOMIC_RELAXED, __HIP_MEMORY_SCOPE_WORKGROUP); } }
            __syncthreads();
            if (tid < 16) { const unsigned n = CNT[tid]; BAS[tid] = n ? xb_add(ecnt + 64 * tid, n) : 0u; }
            __syncthreads();
            if (e_me != 0xffu) { const unsigned pos = BAS[e_me] + li; const int R = ch * 132 + rr_me;
                LIST[(size_t)e_me * MROWS + pos] = (unsigned)R; WL[(size_t)e_me * MROWS + pos] = sl_me ? RW1[rr_me] : RW0[rr_me]; RSLOT[2 * R + sl_me] = (e_me << 16) | pos; }
        }
        __syncthreads();
    }
}
__device__ __forceinline__ int moe_tables(KA a, LAS unsigned char* lds, int l, const int wv) {
    LAS int* tb = (LAS int*)(lds + MISC_TB); LAS int* cn = tb + 32; LAS int* t2e = (LAS int*)(lds + MISC_T2E);
    unsigned* ecnt = (unsigned*)(a->ws + WS_CTL) + CW_ECNT + l * 16 * 64;
    if (wv == 0) { const int ln = lane_fresh(); if (ln < 16) cn[ln] = (int)xb_ld(ecnt + 64 * ln); }
    __syncthreads();
    if (is_t0(wv)) { int acc = 0; for (int e = 0; e < 16; ++e) { const int c = cn[e]; tb[e] = acc; const int nt = (c + 255) >> 8; for (int i = 0; i < nt; ++i) t2e[acc + i] = e; acc += nt; } tb[16] = acc; }
    __syncthreads();
    return tb[16];
}
template <bool DRY = false>
__device__ __forceinline__ void phase_combine(KA a, LAS unsigned char* lds, int l, int G, const int wv) {
    const int tid = fresh_tid(wv), wid = __builtin_amdgcn_readfirstlane(tid >> 6), lane = tid & 63;
    unsigned char* ws = a->ws;
    const float* MODb = (const float*)(ws + WS_MOD); const float* modl = MODb + (size_t)l * 5 * 6144;
    bf16_t* H = (bf16_t*)(ws + WS_H); const bf16_t* Y = (const bf16_t*)(ws + WS_U); const unsigned* RSLOT = (const unsigned*)(ws + WS_RSLOT);
    bf16_t* X1 = (bf16_t*)(ws + WS_X1); float* OUT = a->out;
    const LAS int* tb = (const LAS int*)(lds + MISC_TB);
    ModCoef mc; mc.cls = -1; f32x4 g2[4], fn[4]; int gcls = -1;
#pragma unroll
    for (int j = 0; j < 4; ++j) fn[j] = *(const f32x4*)(a->final_norm + 4 * lane + 256 * j);
    for (int ch = blockIdx.x; ch < 256; ch += G) {
        int rbeg, nrow; wave_rows(ch, wid, rbeg, nrow);
        if (l == 1) { const int b = rbeg / SEG, t = rbeg - b * SEG; if (t >= SEQ) continue; if (t + nrow > SEQ) nrow = SEQ - t; }
        f32x4 xn[4]; u32x2 yn[3][4]; unsigned sn0, sn1;
#define CB_LOADS(R_) do { sn0 = RSLOT[2 * (R_)]; sn1 = RSLOT[2 * (R_) + 1]; } while (0)
#define CB_LOADD(R_) do { const size_t r0_ = (size_t)(256 * tb[sn0 >> 16]) + (sn0 & 0xffffu), r1_ = (size_t)(256 * tb[sn1 >> 16]) + (sn1 & 0xffffu), r2_ = (size_t)SH_OFF + (R_); \
            load_row16_bf(X1 + (size_t)(R_) * DM, lane, xn); \
            _Pragma("unroll") for (int j = 0; j < 4; ++j) { const int c_ = 4 * lane + 256 * j; yn[0][j] = *(const u32x2*)(Y + r0_ * 1024 + c_); yn[1][j] = *(const u32x2*)(Y + r1_ * 1024 + c_); yn[2][j] = *(const u32x2*)(Y + r2_ * 1024 + c_); } } while (0)
        CB_LOADS(rbeg); CB_LOADD(rbeg); if (nrow > 1) CB_LOADS(rbeg + 1);
        for (int i = 0; i < nrow; ++i) {
            f32x4 v[4]; u32x2 y[3][4];
#pragma unroll
            for (int j = 0; j < 4; ++j) { v[j] = xn[j]; y[0][j] = yn[0][j]; y[1][j] = yn[1][j]; y[2][j] = yn[2][j]; }
            if (i + 1 < nrow) CB_LOADD(rbeg + i + 1);
            if (i + 2 < nrow) CB_LOADS(rbeg + i + 2);
            const int R = rbeg + i, b = R / SEG, t = R - b * SEG, cls = t < SEQ ? b : 4;
            if (cls != gcls) { gcls = cls;
#pragma unroll
                for (int j = 0; j < 4; ++j) g2[j] = *(const f32x4*)(modl + cls * 6144 + 5120 + 4 * lane + 256 * j); }
#pragma unroll
            for (int j = 0; j < 4; ++j) { const u32x2 y0 = y[0][j], y1 = y[1][j], y2 = y[2][j];
                const f32x4 ys = {bf_lo(y0.x) + bf_lo(y1.x) + bf_lo(y2.x), bf_hi(y0.x) + bf_hi(y1.x) + bf_hi(y2.x), bf_lo(y0.y) + bf_lo(y1.y) + bf_lo(y2.y), bf_hi(y0.y) + bf_hi(y1.y) + bf_hi(y2.y)};
                v[j] = v[j] + g2[j] * ys; }
            const float rstd = __builtin_amdgcn_rsqf(wave_sum(sumsq16(v)) * (1.f / 1024.f) + EPS);
            if (l == 0) {
                store_row16_bf(DRY ? (bf16_t*)(ws + WS_DRY) + (size_t)(R & 1023) * DM : X1 + (size_t)R * DM, lane, v);
                if (cls != mc.cls) modcoef_load(mc, a->norm_mix + 1024, MODb + (size_t)5 * 6144, cls, 0, lane);
                store_h16(DRY ? (bf16_t*)(ws + WS_DRY + 8 * MiB) + (size_t)(R & 1023) * DM : H + (size_t)R * DM, lane, v, rstd, mc);
            } else {
                float* xr = DRY ? (float*)(ws + WS_DRY) + (size_t)(R & 1023) * DM : OUT + ((size_t)b * SEQ + t) * DM;
#pragma unroll
                for (int j = 0; j < 4; ++j) *(f32x4*)(xr + 4 * lane + 256 * j) = v[j] * rstd * fn[j];
            }
        }
#undef CB_LOADS
#undef CB_LOADD
    }
}

#ifndef PHASE_MASK
#define PHASE_MASK 0xFFFF
#endif
#define PH(k) ((PHASE_MASK >> (k)) & 1)
#ifndef REPEAT_MASK
#define REPEAT_MASK 0
#endif
#define RP(k) (1 + ((REPEAT_MASK >> (k)) & 1))
#define GRID_BAR() do { asm volatile("" : "+s"(bar.bar)); xcd_barrier(bar, wv); } while (0)
template <int l>
__device__ __forceinline__ void layer_body(KA a0, LAS unsigned char* lds, const int G, XcdBarrier& bar, const int wv) {
#define LB_PTRS() KA a = fresh_args(); unsigned char* ws = a->ws; unsigned* ctl = (unsigned*)(ws + WS_CTL); bf16_t* H = (bf16_t*)(ws + WS_H); bf16_t* U = (bf16_t*)(ws + WS_U); bf16_t* ACT = (bf16_t*)(ws + WS_ACT); \
    float* XC = (float*)(ws + WS_XC); const float* MODb = (const float*)(ws + WS_MOD); (void)ctl; (void)H; (void)U; (void)ACT; (void)XC; (void)MODb; (void)a0

        _Pragma("unroll") for (int rep = 0; rep < RP(2); ++rep) { if (rep) GRID_BAR();
        if (PH(2)) { LB_PTRS(); ProbIn p; p.S.init(NTILE, LDU / 256, G, (int)blockIdx.x); p.H = H; p.W = (const bf16_t*)(ws + WS_WINT) + (size_t)l * LDU * 1024; p.U = U;
          pg8::gemm_phase(lds, p, wv); } }
        GRID_BAR();
        if (RP(3) > 1) { phase_post<true>(fresh_args(), lds, l, G, wv); GRID_BAR(); }
        if (PH(3)) phase_post(fresh_args(), lds, l, G, wv);
        GRID_BAR();
        _Pragma("unroll") for (int rep = 0; rep < RP(4); ++rep) { if (rep) GRID_BAR();
        if (PH(4)) { LB_PTRS(); AttnCtx A; A.U = U; A.AO = H; A.relb = a->relb + (size_t)l * 4 * 465; A.subln = a->subln + l * 64; A.lam = ((const float*)(ws + WS_LAM))[l]; A.lam_init = 0.8f - 0.6f * __expf(-0.3f * (float)l);
          attn_phase(A, lds, ctl + CW_QHEAD + (l + 2 * rep) * 4 * 8 * 64, l == 0 ? 33 : 32, bar.x, wv); } }
        GRID_BAR();
        _Pragma("unroll") for (int rep = 0; rep < (l == 0 ? RP(5) : 1); ++rep) { if (rep) GRID_BAR();
        if (PH(5)) { LB_PTRS(); ProbOut p; p.latent_only = l == 1; p.S.init(l == 0 ? NTILE : 128, 4, G, (int)blockIdx.x); p.AO = H; p.W = (const bf16_t*)(ws + WS_WOUTT) + (size_t)l * 1024 * 1024;
          p.XLin = l == 0 ? a->x : nullptr; p.XCin = l == 0 ? a->ctx : nullptr; p.X1 = (bf16_t*)(ws + WS_X1); p.mod = MODb + (size_t)l * 5 * 6144;
          pg8::gemm_phase(lds, p, wv); } }
        GRID_BAR();
        if (RP(6) > 1) { phase_route<true>(fresh_args(), lds, l, G, wv); GRID_BAR(); }
        if (PH(6)) phase_route(fresh_args(), lds, l, G, wv);
        GRID_BAR();
        const int nrt = moe_tables(fresh_args(), lds, l, wv);
        MoeSched ms; ms.G = G; ms.c = (int)blockIdx.x; ms.nrt = nrt; ms.nsh = l == 0 ? NTILE : 128; ms.latent_only = l == 1;
        ms.t2e = (const LAS int*)(lds + MISC_T2E); ms.tb = (const LAS int*)(lds + MISC_TB); ms.cn = ms.tb + 32;
        _Pragma("unroll") for (int rep = 0; rep < RP(7); ++rep) { if (rep) GRID_BAR();
        if (PH(7)) { LB_PTRS(); ProbGU p; p.S = ms; p.S.ncol = 2; p.H = H; p.W = (const bf16_t*)(ws + WS_WGU) + (size_t)l * 17 * 512 * 1024; p.list = (const unsigned*)(ws + WS_LIST); p.ACT = ACT;
          pg8::gemm_phase(lds, p, wv); } }
        GRID_BAR();
        _Pragma("unroll") for (int rep = 0; rep < RP(8); ++rep) { if (rep) GRID_BAR();
        if (PH(8)) { LB_PTRS(); ProbDN p; p.S = ms; p.S.ncol = 4; p.ACT = ACT; p.W = (const bf16_t*)(ws + WS_WDN) + (size_t)l * 17 * 1024 * 256; p.wl = (const float*)(ws + WS_WL); p.Y = U;
          pg8::gemm_phase(lds, p, wv); } }
        GRID_BAR();
        if (RP(9) > 1) { phase_combine<true>(fresh_args(), lds, l, G, wv); GRID_BAR(); }
        if (PH(9)) phase_combine(fresh_args(), lds, l, G, wv);
        if (l == 0) GRID_BAR();
    }
__global__ void __launch_bounds__(512, 2) fwd_kernel(Args a_unused) {
    KA a = fresh_args();
    extern __shared__ __attribute__((aligned(16))) unsigned char lds_raw[];
    LAS unsigned char* lds = (LAS unsigned char*)lds_raw;
    const int tid = threadIdx.x, G = gridDim.x, wv = __builtin_amdgcn_readfirstlane(tid >> 6);
    unsigned char* ws = a->ws;
    unsigned* ctl = (unsigned*)(ws + WS_CTL);
    for (int u = tid; u < (LDS_BYTES - MISC_OFF) / 4; u += 512) ((LAS unsigned*)(lds + MISC_OFF))[u] = 0u;
    __syncthreads();
    XcdBarrier bar = xcd_barrier_post(ctl + CW_BAR, (volatile LAS unsigned*)(lds + MISC_BARW), wv);
    bf16_t* H = (bf16_t*)(ws + WS_H); bf16_t* U = (bf16_t*)(ws + WS_U); bf16_t* ACT = (bf16_t*)(ws + WS_ACT);
    float* XC = (float*)(ws + WS_XC);
    const float* MODb = (const float*)(ws + WS_MOD);
    _Pragma("unroll") for (int rep = 0; rep < RP(0); ++rep) { if (PH(0)) prologue(fresh_args(), lds, G, wv);
    GRID_BAR(); }
    _Pragma("unroll") for (int rep = 0; rep < RP(1); ++rep) { if (PH(1)) phase_norm1(fresh_args(), G, wv);
    GRID_BAR(); }
    layer_body<0>(a, lds, G, bar, wv);
    layer_body<1>(a, lds, G, bar, wv);
}
#undef LB_PTRS

extern "C" void kernel_launch(void* const* d_in, const int* in_sizes, int n_in, void* d_out, int out_size, void* d_ws, size_t ws_size, hipStream_t stream) {
    static int grid = 0;
    if (grid == 0) {
        if (n_in != 31 || in_sizes[0] != NBATCH * SEQ * DM || out_size != NBATCH * SEQ * DM || ws_size < WS_END) {
            fprintf(stderr, "kernel_launch: unexpected shapes (n_in %d, in0 %d, out %d, ws %zu); nothing launched\n", n_in, n_in > 0 ? in_sizes[0] : -1, out_size, ws_size); grid = -1; return; }
        int dev = 0, cus = 0;
        if (hipGetDevice(&dev) != hipSuccess || hipDeviceGetAttribute(&cus, hipDeviceAttributeMultiprocessorCount, dev) != hipSuccess) { grid = -1; return; }
        if (hipFuncSetAttribute((const void*)fwd_kernel, hipFuncAttributeMaxDynamicSharedMemorySize, LDS_BYTES) != hipSuccess) { fprintf(stderr, "kernel_launch: hipFuncSetAttribute failed\n"); grid = -1; return; }
        int per_cu = 0;
        if (hipOccupancyMaxActiveBlocksPerMultiprocessor(&per_cu, (const void*)fwd_kernel, 512, LDS_BYTES) != hipSuccess || per_cu < 1) { fprintf(stderr, "kernel_launch: occupancy query says %d\n", per_cu); }
        (void)hipGetLastError();
        grid = cus;
    }
    if (grid < 0) return;
    if (hipMemsetAsync((char*)d_ws + WS_CTL, 0, CTL_ZERO_BYTES, stream) != hipSuccess) return;
    Args a{};
    const float* const* in = (const float* const*)d_in;
    a.x = in[0]; a.c = in[1]; a.ctx = in[2]; a.c_ctx = in[3]; a.w_mod = in[4]; a.b_mod = in[5]; a.norm_mix = in[6]; a.norm_ffn = in[7]; a.w_in = in[8]; a.w_out = in[9];
    a.gqa_qn = in[10]; a.gqa_kn = in[11]; a.relb = in[12]; a.lq1 = in[13]; a.lk1 = in[14]; a.lq2 = in[15]; a.lk2 = in[16]; a.subln = in[17];
    a.mla_qn = in[18]; a.mla_wqu = in[19]; a.mla_kvn = in[20]; a.mla_wkvu = in[21]; a.router_w = in[22]; a.router_b = in[23];
    a.wg = in[24]; a.wu = in[25]; a.wd = in[26]; a.sg = in[27]; a.su = in[28]; a.sd = in[29]; a.final_norm = in[30];
    a.out = (float*)d_out; a.ws = (unsigned char*)d_ws;
    hipLaunchKernelGGL(fwd_kernel, dim3(grid), dim3(512), LDS_BYTES, stream, a);
}
```

```cpp
#include <hip/hip_runtime.h>
#include <cstdio>
#include <cstdint>

#define LAS __attribute__((address_space(3)))
#define GAS __attribute__((address_space(1)))
typedef unsigned short bf16_t;
typedef short bf16x8 __attribute__((ext_vector_type(8)));
typedef short s16x4 __attribute__((ext_vector_type(4)));
typedef short v4i16_t __attribute__((ext_vector_type(4)));
typedef float f32x2 __attribute__((ext_vector_type(2)));
typedef float f32x4 __attribute__((ext_vector_type(4)));
typedef float f32x16 __attribute__((ext_vector_type(16)));
typedef unsigned u32x2 __attribute__((ext_vector_type(2)));
typedef unsigned u32x4 __attribute__((ext_vector_type(4)));
typedef __bf16 bf16x2_t __attribute__((ext_vector_type(2)));

constexpr int DM = 1024, NBATCH = 4, SEQ = 8192, CTXL = 256, SEG = SEQ + CTXL, MROWS = NBATCH * SEG, NTILE = MROWS / 256;
constexpr int NLAYER = 2, INCOLS = 2400, LDU = 3328, NEXP = 16;
constexpr int A_Q = 0, A_K = 256, A_V = 384, B_Q = 512, B_K = 768, B_V = 1024, C_Q = 1280, C_K = 1536, C_V = 1792;
constexpr int D_CQ = 2048, D_CKV = 2240, D_KPE = 2368, D_Q = 2400, D_KN = 2784, D_V = 3040, U_PAD0 = 3296;
constexpr float EPS = 1e-6f, LOG2E = 1.4426950408889634f;
constexpr float QS32 = 0.17677669529663687f * LOG2E, QS64 = 0.125f * LOG2E, QS96 = 0.10206207261596577f * LOG2E;
constexpr int SH_OFF = 71680, SLOT_ROWS = SH_OFF + MROWS;

constexpr size_t MiB = 1u << 20;
constexpr size_t WS_CTL = 0, CTL_ZERO_BYTES = 1 * MiB;
constexpr size_t WS_MOD = 1 * MiB;
constexpr size_t WS_LAM = WS_MOD + 256 * 1024;
constexpr size_t WS_LIST = 2 * MiB;
constexpr size_t WS_WL = 5 * MiB;
constexpr size_t WS_RSLOT = 8 * MiB;
constexpr size_t WS_XC = 9 * MiB;
constexpr size_t WS_WINT = 16 * MiB;
constexpr size_t WS_WOUTT = 29 * MiB;
constexpr size_t WS_WGU = 33 * MiB;
constexpr size_t WS_WDN = 67 * MiB;
constexpr size_t WS_H = 84 * MiB;
constexpr size_t WS_U = 150 * MiB;
constexpr size_t WS_ACT = 365 * MiB;
constexpr size_t WS_X1 = 418 * MiB;
constexpr size_t WS_END = 485 * MiB;
constexpr size_t WS_DRY = 488 * MiB;
static_assert(WS_WINT + (size_t)NLAYER * LDU * DM * 2 <= WS_WOUTT && WS_WGU + (size_t)NLAYER * 17 * 512 * 1024 * 2 <= WS_WDN && WS_WDN + (size_t)NLAYER * 17 * 1024 * 256 * 2 <= WS_H, "ws map");
static_assert(WS_H + (size_t)MROWS * DM * 2 <= WS_U && WS_U + (size_t)MROWS * LDU * 2 <= WS_ACT && WS_U + (size_t)SLOT_ROWS * 1024 * 2 <= WS_ACT && WS_ACT + (size_t)SLOT_ROWS * 256 * 2 <= WS_X1 && WS_X1 + (size_t)MROWS * DM * 2 <= WS_END, "ws map");
constexpr int CW_BAR = 4096;
constexpr int CW_QHEAD = 16384;
constexpr int CW_ECNT = 32768;

constexpr int RING_BYTES = 147456, MISC_OFF = 147456, LDS_BYTES = 151552;
constexpr int MISC_BARW = MISC_OFF + 32;
constexpr int MISC_POP = MISC_OFF + 64;
constexpr int MISC_TB = MISC_OFF + 256;
constexpr int MISC_T2E = MISC_OFF + 512;

__device__ __forceinline__ int lane_fresh() { int l; asm volatile("v_mbcnt_lo_u32_b32 %0, -1, 0\n\tv_mbcnt_hi_u32_b32 %0, -1, %0" : "=v"(l)); return l; }
__device__ __forceinline__ unsigned cvtpk(float lo, float hi) { f32x2 v = {lo, hi}; bf16x2_t b = __builtin_convertvector(v, bf16x2_t); return __builtin_bit_cast(unsigned, b); }
__device__ __forceinline__ float bf_lo(unsigned w) { return __uint_as_float(w << 16); }
__device__ __forceinline__ float bf_hi(unsigned w) { return __uint_as_float(w & 0xffff0000u); }
__device__ __forceinline__ float wave_sum(float v) {
    v += __int_as_float(__builtin_amdgcn_update_dpp(0, __float_as_int(v), 0xB1, 0xf, 0xf, true));
    v += __int_as_float(__builtin_amdgcn_update_dpp(0, __float_as_int(v), 0x4E, 0xf, 0xf, true));
    v += __int_as_float(__builtin_amdgcn_update_dpp(0, __float_as_int(v), 0x141, 0xf, 0xf, true));
    v += __int_as_float(__builtin_amdgcn_update_dpp(0, __float_as_int(v), 0x140, 0xf, 0xf, true));
    { auto p = __builtin_amdgcn_permlane16_swap(__float_as_uint(v), __float_as_uint(v), false, false); v = __uint_as_float(p[0]) + __uint_as_float(p[1]); }
    { auto p = __builtin_amdgcn_permlane32_swap(__float_as_uint(v), __float_as_uint(v), false, false); v = __uint_as_float(p[0]) + __uint_as_float(p[1]); }
    return v;
}
#define DPPF(x_, c_) __int_as_float(__builtin_amdgcn_update_dpp(0, __float_as_int(x_), (c_), 0xf, 0xf, true))
__device__ __forceinline__ float lane_xor1(float x) { return DPPF(x, 0xB1); }
__device__ __forceinline__ float lane_xor2(float x) { return DPPF(x, 0x4E); }
__device__ __forceinline__ float lane_xor4(float x) { const float y = DPPF(x, 0x141); return DPPF(y, 0x1B); }
__device__ __forceinline__ float lane_xor8(float x) { return DPPF(x, 0x128); }
__device__ __forceinline__ float row16_sum(float v) { v += DPPF(v, 0xB1); v += DPPF(v, 0x4E); v += DPPF(v, 0x141); v += DPPF(v, 0x140); return v; }
__device__ __forceinline__ int crow(int r, int hi) { return (r & 3) + 8 * (r >> 2) + 4 * hi; }
#define LDS_WAIT() asm volatile("s_waitcnt lgkmcnt(0)" ::: "memory")

#define XB_TMO      128
#define XB_XCNT(j)  (256  + 64 * (j))
#define XB_XSUB(j)  (1280 + 64 * (j))
#define XB_XGEN(j)  (2304 + 64 * (j))
#define XB_TOP      3328
#define XB_TOPGEN   3392
#define XCD_BAR_WORDS 3456
#define XB_SPIN_CAP (1u << 18)
__device__ __forceinline__ unsigned xb_ld(unsigned* p)              { return __hip_atomic_load(p, __ATOMIC_RELAXED, __HIP_MEMORY_SCOPE_AGENT); }
__device__ __forceinline__ unsigned xb_add(unsigned* p, unsigned v) { return __hip_atomic_fetch_add(p, v, __ATOMIC_RELAXED, __HIP_MEMORY_SCOPE_AGENT); }
__device__ __forceinline__ unsigned xb_xcc_id() { return (unsigned)__builtin_amdgcn_s_getreg((3 << 11) | 20) & 0xFu; }
#define XB_SPIN(cond, bar) do { unsigned _sp = 0; while (cond) { __builtin_amdgcn_s_sleep(1); \
    if ((++_sp & 255u) == 0u) { if (xb_ld(&(bar)[XB_TMO])) break; if (_sp > XB_SPIN_CAP) { atomicAdd(&(bar)[XB_TMO], 1u); break; } } } } while (0)
struct XcdBarrier { unsigned* bar; unsigned x; volatile LAS unsigned* st; };
__device__ __forceinline__ bool is_t0(int wv) { return wv == 0 && lane_fresh() == 0; }
__device__ __forceinline__ XcdBarrier xcd_barrier_post(unsigned* bar, volatile LAS unsigned* st, int wv) {
    XcdBarrier b; b.bar = bar; b.x = xb_xcc_id(); b.st = st;
    if (is_t0(wv)) (void)xb_add(&bar[XB_XCNT(b.x)], 1u);
    return b;
}
__device__ __forceinline__ void xcd_barrier_complete(unsigned* bar, unsigned x, unsigned& nloc, unsigned& nx) {
    const unsigned G = gridDim.x * gridDim.y * gridDim.z;
    unsigned sum, cnt, mine, sp = 0u;
    for (;;) {
        sum = 0u; cnt = 0u; mine = 0u;
#pragma unroll
        for (unsigned j = 0; j < 16; ++j) { const unsigned c = xb_ld(&bar[XB_XCNT(j)]); sum += c; cnt += (c > 0u) ? 1u : 0u; mine = (j == x) ? c : mine; }
        if (sum == G) break;
        __builtin_amdgcn_s_sleep(1);
        if ((++sp & 255u) == 0u) { if (xb_ld(&bar[XB_TMO])) break; if (sp > XB_SPIN_CAP) { atomicAdd(&bar[XB_TMO], 1u); break; } }
    }
    nloc = mine > 0u ? mine : 1u; nx = cnt > 0u ? cnt : 1u;
}
__device__ __forceinline__ void xcd_barrier(const XcdBarrier& b, int wv) {
    asm volatile("s_waitcnt vmcnt(0)" ::: "memory");
    __syncthreads();
    if (is_t0(wv)) {
        unsigned* bar = b.bar;
        __builtin_amdgcn_s_waitcnt(0);
        unsigned nloc = b.st[0], nx = b.st[1];
        if (nloc == 0u) { xcd_barrier_complete(bar, b.x, nloc, nx); b.st[0] = nloc; b.st[1] = nx; }
        const unsigned old = xb_add(&bar[XB_XSUB(b.x)], 1u);
        const unsigned gen = old / nloc;
        if (old + 1u == (gen + 1u) * nloc) {
            __builtin_amdgcn_fence(__ATOMIC_RELEASE, "agent");
            asm volatile("s_waitcnt vmcnt(0)" ::: "memory");
            const unsigned og = xb_add(&bar[XB_TOP], 1u);
            const unsigned tg = og / nx;
            if (og + 1u == (tg + 1u) * nx) xb_add(&bar[XB_TOPGEN], 1u);
            else XB_SPIN(xb_ld(&bar[XB_TOPGEN]) == tg, bar);
            __builtin_amdgcn_fence(__ATOMIC_ACQUIRE, "agent");
            xb_add(&bar[XB_XGEN(b.x)], 1u);
            asm volatile("s_waitcnt vmcnt(0)" ::: "memory");
        } else {
            XB_SPIN(xb_ld(&bar[XB_XGEN(b.x)]) == gen, bar);
            __builtin_amdgcn_fence(__ATOMIC_ACQUIRE, "agent");
            asm volatile("s_waitcnt vmcnt(0)" ::: "memory");
        }
    }
    __syncthreads();
}

struct Args {
    const float* x; const float* c; const float* ctx; const float* c_ctx; const float* w_mod; const float* b_mod;
    const float* norm_mix; const float* norm_ffn; const float* w_in; const float* w_out;
    const float* gqa_qn; const float* gqa_kn; const float* relb; const float* lq1; const float* lk1; const float* lq2; const float* lk2; const float* subln;
    const float* mla_qn; const float* mla_wqu; const float* mla_kvn; const float* mla_wkvu; const float* router_w; const float* router_b;
    const float* wg; const float* wu; const float* wd; const float* sg; const float* su; const float* sd; const float* final_norm;
    float* out; unsigned char* ws;
};

typedef const __attribute__((address_space(4))) Args* KA;
__device__ __forceinline__ KA fresh_args() { KA p = (KA)__builtin_amdgcn_kernarg_segment_ptr(); asm volatile("" : "+s"(p)); return p; }
__device__ __forceinline__ int fresh_tid(int wv) { return wv * 64 + lane_fresh(); }
__device__ __forceinline__ const float* xrow_in(const float* XL, const float* XC, int R) {
    const int b = R / SEG, t = R - b * SEG;
    return t < SEQ ? XL + ((size_t)b * SEQ + t) * DM : XC + ((size_t)b * CTXL + (t - SEQ)) * DM;
}
__device__ __forceinline__ float* xrow_out(float* XL, float* XC, int R) {
    const int b = R / SEG, t = R - b * SEG;
    return t < SEQ ? XL + ((size_t)b * SEQ + t) * DM : XC + ((size_t)b * CTXL + (t - SEQ)) * DM;
}

namespace pg8 {
constexpr int BM = 256, BK = 64, HALF = 128, HTB = HALF * BK * 2, STAGE_BYTES = 8 * HTB, NXCD = 8, WGM = 8;
__device__ __forceinline__ int lds_byte(int r, int c) { const int st = (r >> 4) * 2 + (c >> 5), rr = r & 15, cc = c & 31, ob = rr * 64 + cc * 2; return st * 1024 + (ob ^ (((ob >> 9) & 1) << 5)); }
__device__ __forceinline__ void stage_rc(int b, int& R, int& C) { const int st = b / 1024, sb = b % 1024, swz = sb ^ (((sb >> 9) & 1) << 5); R = (st >> 1) * 16 + swz / 64; C = (st & 1) * 32 + (swz % 64) / 2; }
__device__ __forceinline__ int perm32(int rho) { const int n = rho >> 4, i = rho & 15; return 8 * (i >> 2) + 4 * n + (i & 3); }
struct Unit { int pm, pn, e, lt; };
struct StaticOrder {
    int nM, nN, nwg, G, c;
    __device__ void init(int nM_, int nN_, int G_, int c_) { nM = nM_; nN = nN_; nwg = nM * nN; G = G_; c = c_; }
    __device__ bool next(int i, Unit& u) const {
        const long L = (long)i * G + c; if (L >= nwg) return false;
        int wgid = (int)L; { const int q = nwg / NXCD, r = nwg % NXCD, xcd = wgid % NXCD, off = wgid / NXCD; wgid = (xcd < r ? xcd * (q + 1) : r * (q + 1) + (xcd - r) * q) + off; }
        const int nig = WGM * nN, gid = wgid / nig, fm = gid * WGM, gsz = (nM - fm) < WGM ? (nM - fm) : WGM;
        u.pm = fm + ((wgid % nig) % gsz); u.pn = (wgid % nig) / gsz; u.e = 0; u.lt = 0; return true;
    }
};

template <class P>
__device__ __forceinline__ void gemm_phase(LAS unsigned char* lds, const P& pb, const int wv) {
    constexpr int K = P::K, nt = K / BK;
    static_assert(nt % 2 == 0 && nt >= 2, "K must be a multiple of 128");
    const int tid = fresh_tid(wv), wid = __builtin_amdgcn_readfirstlane(tid >> 6), lane = tid & 63, wr = wid >> 2, wc = wid & 3, fr = lane & 15, fq = lane >> 4;
    int Rr[2]; unsigned cb[2], voffB[2];
#pragma unroll
    for (int i = 0; i < 2; ++i) { int R, C; stage_rc(tid * 16 + i * 8192, R, C); const int Rb = P::PERM ? ((R & ~31) + perm32(R & 31)) : R;
        Rr[i] = R; cb[i] = (unsigned)C * 2u; voffB[i] = (unsigned)(Rb * K + C) * 2u; }
    constexpr size_t kstep = (size_t)(BK * 2);
    constexpr size_t hstep = (size_t)HALF * K * 2;
    const unsigned ldsw = (unsigned)wid * 1024u;
    const int aoff = lds_byte(wr * 64 + fr, fq * 8), boff = lds_byte(wc * 32 + fr, fq * 8);
    const char* Abase = pb.a_base();
#define PG8_SA(b, h) (((b) * 2 + (h)) * HTB)
#define PG8_SB(b, h) ((4 + (b) * 2 + (h)) * HTB)
#define PG8_STAGE(bufoff, gbase, voff) do { _Pragma("unroll") for (int _i = 0; _i < 2; ++_i) \
        __builtin_amdgcn_global_load_lds((const unsigned*)((const char*)(gbase) + (voff)[_i]), (LAS unsigned*)(lds + (bufoff) + ldsw + _i * 8192), 16, 0, 0); } while (0)
#define PG8_STAGE_A(bufoff, offs, kb) do { const char* _sb = Abase + (size_t)(kb); _Pragma("unroll") for (int _i = 0; _i < 2; ++_i) \
        __builtin_amdgcn_global_load_lds((const unsigned*)(_sb + (offs)[_i]), (LAS unsigned*)(lds + (bufoff) + ldsw + _i * 8192), 16, 0, 0); } while (0)
#define PG8_LDA(dst, b, h) do { _Pragma("unroll") for (int m = 0; m < 4; ++m) _Pragma("unroll") for (int k = 0; k < 2; ++k) dst[m][k] = *(const LAS bf16x8*)(lds + PG8_SA(b, h) + aoff + m * 2048 + k * 1024); } while (0)
#define PG8_LDB(dst, b, h) do { _Pragma("unroll") for (int n = 0; n < 2; ++n) _Pragma("unroll") for (int k = 0; k < 2; ++k) dst[n][k] = *(const LAS bf16x8*)(lds + PG8_SB(b, h) + boff + n * 2048 + k * 1024); } while (0)
#define PG8_MMA(ai, bj, At, Bt) do { __builtin_amdgcn_s_setprio(1); _Pragma("unroll") for (int m = 0; m < 4; ++m) _Pragma("unroll") for (int n = 0; n < 2; ++n) _Pragma("unroll") for (int k = 0; k < 2; ++k) \
        acc[ai][bj][m][n] = __builtin_amdgcn_mfma_f32_16x16x32_bf16(Bt[n][k], At[m][k], acc[ai][bj][m][n], 0, 0, 0); __builtin_amdgcn_s_setprio(0); } while (0)
#define PG8_WAIT_V(n) asm volatile("s_waitcnt vmcnt(" #n ")" ::: "memory")
#define PG8_WAIT_L(n) asm volatile("s_waitcnt lgkmcnt(" #n ")" ::: "memory")
#define PG8_BAR __builtin_amdgcn_s_barrier()
#define PG8_SCHED __builtin_amdgcn_sched_barrier(0)
    Unit cur, nxt; int ui = 0;
    if (!pb.next(0, cur)) return;
    f32x4 acc[2][2][4][2];
#pragma unroll
    for (int a = 0; a < 2; ++a)
#pragma unroll
        for (int b = 0; b < 2; ++b)
#pragma unroll
            for (int m = 0; m < 4; ++m)
#pragma unroll
                for (int n = 0; n < 2; ++n) acc[a][b][m][n] = (f32x4){0.f, 0.f, 0.f, 0.f};
    bf16x8 At[4][2], B0[2][2], B1[2][2];
    unsigned ao[2][2];
    pb.a_offs(cur, Rr, ao);
#pragma unroll
    for (int h = 0; h < 2; ++h)
#pragma unroll
        for (int i = 0; i < 2; ++i) ao[h][i] += cb[i];
    const char* cB = pb.b_base(cur);
    PG8_STAGE(PG8_SB(0, 0), cB, voffB); PG8_STAGE(PG8_SB(0, 1), cB + hstep, voffB); PG8_STAGE_A(PG8_SA(0, 0), ao[0], 0); PG8_STAGE_A(PG8_SA(0, 1), ao[1], 0);
    if (wr == 1) PG8_BAR;
    PG8_WAIT_V(2); PG8_BAR;
    PG8_STAGE(PG8_SB(1, 0), cB + kstep, voffB); PG8_STAGE_A(PG8_SA(1, 0), ao[0], kstep); PG8_STAGE(PG8_SB(1, 1), cB + hstep + kstep, voffB);
    PG8_WAIT_V(6); PG8_BAR;
    for (;;) {
        const bool has_next = pb.next(ui + 1, nxt);
        const char* nB = has_next ? pb.b_base(nxt) : cB;
#pragma unroll 1
        for (int t = 0; t < nt; t += 2) {
            const bool last = (t == nt - 2);
            const size_t k1 = (size_t)(t + 1) * kstep;
            PG8_LDB(B0, 0, 0); PG8_LDB(B1, 0, 1); PG8_SCHED; PG8_LDA(At, 0, 0); PG8_STAGE_A(PG8_SA(1, 1), ao[1], k1);
            const char* b2 = last ? nB : cB + (size_t)(t + 2) * kstep; const char* b3 = b2 + kstep;
            size_t k2 = (size_t)(t + 2) * kstep;
            if (last) { k2 = 0;
                if (has_next) { pb.a_offs(nxt, Rr, ao);
#pragma unroll
                    for (int h = 0; h < 2; ++h)
#pragma unroll
                        for (int i = 0; i < 2; ++i) ao[h][i] += cb[i]; } }
            const size_t k3 = k2 + kstep;
            PG8_WAIT_V(8); PG8_WAIT_L(0); PG8_BAR; PG8_MMA(0, 0, At, B0); PG8_MMA(0, 1, At, B1); PG8_BAR; PG8_SCHED;
            PG8_LDA(At, 0, 1); PG8_STAGE(PG8_SB(0, 0), b2, voffB); PG8_STAGE(PG8_SB(0, 1), b2 + hstep, voffB); PG8_STAGE_A(PG8_SA(0, 0), ao[0], k2);
            PG8_WAIT_V(8); PG8_WAIT_L(0); PG8_BAR; PG8_MMA(1, 0, At, B0); PG8_MMA(1, 1, At, B1); PG8_BAR; PG8_SCHED;
            PG8_LDB(B0, 1, 0); PG8_LDB(B1, 1, 1); PG8_SCHED; PG8_LDA(At, 1, 0); PG8_STAGE_A(PG8_SA(0, 1), ao[1], k2);
            PG8_WAIT_V(8); PG8_WAIT_L(0); PG8_BAR; PG8_MMA(0, 0, At, B0); PG8_MMA(0, 1, At, B1); PG8_BAR; PG8_SCHED;
            PG8_LDA(At, 1, 1); PG8_STAGE(PG8_SB(1, 0), b3, voffB); PG8_STAGE(PG8_SB(1, 1), b3 + hstep, voffB); PG8_STAGE_A(PG8_SA(1, 0), ao[0], k3);
            PG8_WAIT_V(8); PG8_WAIT_L(0); PG8_BAR; PG8_MMA(1, 0, At, B0); PG8_MMA(1, 1, At, B1); PG8_BAR; PG8_SCHED;
        }
        if (wr == 0) PG8_BAR;
        pb.epi(acc, cur, wr, wc, fr, fq);
        if (!has_next) break;
#pragma unroll
        for (int a = 0; a < 2; ++a)
#pragma unroll
            for (int b = 0; b < 2; ++b)
#pragma unroll
                for (int m = 0; m < 4; ++m)
#pragma unroll
                    for (int n = 0; n < 2; ++n) acc[a][b][m][n] = (f32x4){0.f, 0.f, 0.f, 0.f};
        cur = nxt; cB = nB; ++ui;
        if (wr == 1) PG8_BAR;
    }
    PG8_WAIT_V(0);
    PG8_BAR;
#undef PG8_SA
#undef PG8_SB
#undef PG8_STAGE
#undef PG8_STAGE_A
#undef PG8_LDA
#undef PG8_LDB
#undef PG8_MMA
#undef PG8_WAIT_V
#undef PG8_WAIT_L
#undef PG8_BAR
#undef PG8_SCHED
}
}
using pg8::Unit;
typedef f32x4 Acc[2][2][4][2];

struct ProbIn {
    static constexpr int K = 1024; static constexpr bool PERM = true;
    pg8::StaticOrder S; const bf16_t* H; const bf16_t* W; bf16_t* U;
    __device__ __forceinline__ bool next(int i, Unit& u) const { return S.next(i, u); }
    __device__ __forceinline__ const char* a_base() const { return (const char*)H; }
    __device__ __forceinline__ void a_offs(const Unit& u, const int (&R)[2], unsigned (&off)[2][2]) const {
#pragma unroll
        for (int h = 0; h < 2; ++h)
#pragma unroll
            for (int i = 0; i < 2; ++i) off[h][i] = (unsigned)(u.pm * 256 + h * 128 + R[i]) * 2048u; }
    __device__ __forceinline__ const char* b_base(const Unit& u) const { return (const char*)(W + (size_t)u.pn * 256 * 1024); }
    __device__ __forceinline__ void epi(const Acc& acc, const Unit& u, int wr, int wc, int fr, int fq) const {
        const int row0 = u.pm * 256 + wr * 64 + fr, col0 = u.pn * 256 + wc * 32 + 8 * fq;
        const float qs = u.pn == 2 ? QS64 : (u.pn == 5 ? QS32 : 1.f);
#pragma unroll
        for (int ai = 0; ai < 2; ++ai)
#pragma unroll
            for (int m = 0; m < 4; ++m) { bf16_t* rowp = U + (size_t)(row0 + ai * 128 + m * 16) * LDU + col0;
#pragma unroll
                for (int bj = 0; bj < 2; ++bj) { const f32x4 v0 = acc[ai][bj][m][0] * qs, v1 = acc[ai][bj][m][1] * qs;
                    u32x4 w; w.x = cvtpk(v0[0], v0[1]); w.y = cvtpk(v0[2], v0[3]); w.z = cvtpk(v1[0], v1[1]); w.w = cvtpk(v1[2], v1[3]);
                    *(u32x4*)(rowp + bj * 128) = w; } }
    }
};
struct ProbOut {
    static constexpr int K = 1024; static constexpr bool PERM = true;
    pg8::StaticOrder S; const bf16_t* AO; const bf16_t* W; const float* XLin; const float* XCin; bf16_t* X1; const float* mod; int latent_only;
    __device__ __forceinline__ int tile(int jm) const { return latent_only ? jm + jm / 32 : jm; }
    __device__ __forceinline__ bool next(int i, Unit& u) const { return S.next(i, u); }
    __device__ __forceinline__ const char* a_base() const { return (const char*)AO; }
    __device__ __forceinline__ void a_offs(const Unit& u, const int (&R)[2], unsigned (&off)[2][2]) const {
        const int p = tile(u.pm);
#pragma unroll
        for (int h = 0; h < 2; ++h)
#pragma unroll
            for (int i = 0; i < 2; ++i) off[h][i] = (unsigned)(p * 256 + h * 128 + R[i]) * 2048u; }
    __device__ __forceinline__ const char* b_base(const Unit& u) const { return (const char*)(W + (size_t)u.pn * 256 * 1024); }
    __device__ __forceinline__ void epi(const Acc& acc, const Unit& u, int wr, int wc, int fr, int fq) const {
        asm volatile("" : "+v"(fr));
        const int p = tile(u.pm), b = p / 33, tp = p - b * 33, cls = tp == 32 ? 4 : b;
        const float* xin = nullptr;
        if (XLin) xin = tp < 32 ? XLin + ((size_t)b * SEQ + tp * 256) * DM : XCin + (size_t)b * CTXL * DM;
        bf16_t* xo = X1 + (size_t)p * 256 * DM;
        const float* g1 = mod + cls * 6144 + 2048;
        const int col0 = u.pn * 256 + wc * 32 + 8 * fq;
        f32x4 gv[2][2];
#pragma unroll
        for (int bj = 0; bj < 2; ++bj)
#pragma unroll
            for (int n = 0; n < 2; ++n) gv[bj][n] = *(const f32x4*)(g1 + col0 + bj * 128 + n * 4);
        if (xin) {
#pragma unroll
            for (int ai = 0; ai < 2; ++ai)
#pragma unroll
                for (int mh = 0; mh < 2; ++mh) {
                    f32x4 x0[2][2], x1[2][2];
#pragma unroll
                    for (int mm = 0; mm < 2; ++mm)
#pragma unroll
                        for (int bj = 0; bj < 2; ++bj) { const size_t off = (size_t)(ai * 128 + wr * 64 + (2 * mh + mm) * 16 + fr) * DM + col0; x0[mm][bj] = *(const f32x4*)(xin + off + bj * 128); x1[mm][bj] = *(const f32x4*)(xin + off + bj * 128 + 4); }
                    __builtin_amdgcn_sched_barrier(0);
#pragma unroll
                    for (int mm = 0; mm < 2; ++mm)
#pragma unroll
                        for (int bj = 0; bj < 2; ++bj) { const int m = 2 * mh + mm; const size_t off = (size_t)(ai * 128 + wr * 64 + m * 16 + fr) * DM + col0;
                            const f32x4 v0 = x0[mm][bj] + gv[bj][0] * acc[ai][bj][m][0], v1 = x1[mm][bj] + gv[bj][1] * acc[ai][bj][m][1];
                            u32x4 o; o.x = cvtpk(v0[0], v0[1]); o.y = cvtpk(v0[2], v0[3]); o.z = cvtpk(v1[0], v1[1]); o.w = cvtpk(v1[2], v1[3]);
                            *(u32x4*)(xo + off + bj * 128) = o; }
                    __builtin_amdgcn_sched_barrier(0);
                }
        } else {
#pragma unroll
            for (int ai = 0; ai < 2; ++ai) {
                u32x4 rw[4][2];
#pragma unroll
                for (int m = 0; m < 4; ++m)
#pragma unroll
                    for (int bj = 0; bj < 2; ++bj) { const size_t off = (size_t)(ai * 128 + wr * 64 + m * 16 + fr) * DM + col0; rw[m][bj] = *(const u32x4*)(xo + off + bj * 128); }
                __builtin_amdgcn_sched_barrier(0);
#pragma unroll
                for (int m = 0; m < 4; ++m)
#pragma unroll
                    for (int bj = 0; bj < 2; ++bj) { const size_t off = (size_t)(ai * 128 + wr * 64 + m * 16 + fr) * DM + col0; const u32x4 w = rw[m][bj];
                        const f32x4 x0 = {bf_lo(w.x), bf_hi(w.x), bf_lo(w.y), bf_hi(w.y)}, x1 = {bf_lo(w.z), bf_hi(w.z), bf_lo(w.w), bf_hi(w.w)};
                        const f32x4 v0 = x0 + gv[bj][0] * acc[ai][bj][m][0], v1 = x1 + gv[bj][1] * acc[ai][bj][m][1];
                        u32x4 o; o.x = cvtpk(v0[0], v0[1]); o.y = cvtpk(v0[2], v0[3]); o.z = cvtpk(v1[0], v1[1]); o.w = cvtpk(v1[2], v1[3]);
                        *(u32x4*)(xo + off + bj * 128) = o; }
                __builtin_amdgcn_sched_barrier(0);
            }
        }
    }
};
struct MoeSched {
    int G, c, ncol, nrt, nsh, latent_only; const LAS int* t2e; const LAS int* tb; const LAS int* cn;
    __device__ __forceinline__ int shtile(int jm) const { return latent_only ? jm + jm / 32 : jm; }
    __device__ __forceinline__ bool next(int i, Unit& u) const {
        const int L = i * G + c; if (L >= (nrt + nsh) * ncol) return false;
        const int rt = L / ncol; u.pn = L - rt * ncol;
        if (rt < nrt) { u.pm = rt; u.e = t2e[rt]; u.lt = rt - tb[u.e]; } else { u.pm = 1024 + shtile(rt - nrt); u.e = 16; u.lt = 0; }
        return true;
    }
};
struct ProbGU {
    static constexpr int K = 1024; static constexpr bool PERM = true;
    MoeSched S; const bf16_t* H; const bf16_t* W; const unsigned* list; bf16_t* ACT;
    __device__ __forceinline__ bool next(int i, Unit& u) const { return S.next(i, u); }
    __device__ __forceinline__ const char* a_base() const { return (const char*)H; }
    __device__ __forceinline__ void a_offs(const Unit& u, const int (&R)[2], unsigned (&off)[2][2]) const {
        if (u.pm < 1024) { const int cnt = S.cn[u.e]; const unsigned* lp = list + (size_t)u.e * MROWS;
#pragma unroll
            for (int h = 0; h < 2; ++h)
#pragma unroll
                for (int i = 0; i < 2; ++i) { const int pos = u.lt * 256 + h * 128 + R[i]; const unsigned src = pos < cnt ? lp[pos] : 0u; off[h][i] = src * 2048u; }
        } else { const int p = u.pm - 1024;
#pragma unroll
            for (int h = 0; h < 2; ++h)
#pragma unroll
                for (int i = 0; i < 2; ++i) off[h][i] = (unsigned)(p * 256 + h * 128 + R[i]) * 2048u; }
    }
    __device__ __forceinline__ const char* b_base(const Unit& u) const { return (const char*)(W + ((size_t)u.e * 512 + u.pn * 256) * 1024); }
    __device__ __forceinline__ void epi(const Acc& acc, const Unit& u, int wr, int wc, int fr, int fq) const {
        const int srow0 = (u.pm < 1024 ? u.pm * 256 : SH_OFF + (u.pm - 1024) * 256) + wr * 64 + fr, col0 = u.pn * 128 + wc * 32 + 8 * fq;
#pragma unroll
        for (int ai = 0; ai < 2; ++ai)
#pragma unroll
            for (int m = 0; m < 4; ++m) { float v[8];
#pragma unroll
                for (int n = 0; n < 2; ++n)
#pragma unroll
                    for (int j = 0; j < 4; ++j) { const float g = acc[ai][0][m][n][j], uu = acc[ai][1][m][n][j]; v[n * 4 + j] = g * __builtin_amdgcn_rcpf(1.f + __builtin_amdgcn_exp2f(-g * LOG2E)) * uu; }
                u32x4 w; w.x = cvtpk(v[0], v[1]); w.y = cvtpk(v[2], v[3]); w.z = cvtpk(v[4], v[5]); w.w = cvtpk(v[6], v[7]);
                *(u32x4*)(ACT + (size_t)(srow0 + ai * 128 + m * 16) * 256 + col0) = w; }
    }
};
struct ProbDN {
    static constexpr int K = 256; static constexpr bool PERM = true;
    MoeSched S; const bf16_t* ACT; const bf16_t* W; const float* wl; bf16_t* Y;
    __device__ __forceinline__ bool next(int i, Unit& u) const { return S.next(i, u); }
    __device__ __forceinline__ const char* a_base() const { return (const char*)ACT; }
    __device__ __forceinline__ void a_offs(const Unit& u, const int (&R)[2], unsigned (&off)[2][2]) const {
        const int sr = u.pm < 1024 ? u.pm * 256 : SH_OFF + (u.pm - 1024) * 256;
#pragma unroll
        for (int h = 0; h < 2; ++h)
#pragma unroll
            for (int i = 0; i < 2; ++i) off[h][i] = (unsigned)(sr + h * 128 + R[i]) * 512u; }
    __device__ __forceinline__ const char* b_base(const Unit& u) const { return (const char*)(W + ((size_t)u.e * 1024 + u.pn * 256) * 256); }
    __device__ __forceinline__ void epi(const Acc& acc, const Unit& u, int wr, int wc, int fr, int fq) const {
        const bool routed = u.pm < 1024;
        const int srow0 = (routed ? u.pm * 256 : SH_OFF + (u.pm - 1024) * 256) + wr * 64 + fr, col0 = u.pn * 256 + wc * 32 + 8 * fq;
        const int cnt = routed ? S.cn[u.e] : 0; const float* wp = wl + (size_t)(routed ? u.e : 0) * MROWS;
        float gwv[2][4];
#pragma unroll
        for (int ai = 0; ai < 2; ++ai)
#pragma unroll
            for (int m = 0; m < 4; ++m) { const int rl = ai * 128 + wr * 64 + m * 16 + fr; float gw = 1.f;
                if (routed) { const int pos = u.lt * 256 + rl; gw = pos < cnt ? wp[pos] : 0.f; }
                gwv[ai][m] = gw; }
        __builtin_amdgcn_sched_barrier(0);
#pragma unroll
        for (int ai = 0; ai < 2; ++ai)
#pragma unroll
            for (int m = 0; m < 4; ++m) { const float gw = gwv[ai][m];
                bf16_t* rowp = Y + (size_t)(srow0 + ai * 128 + m * 16) * 1024 + col0;
#pragma unroll
                for (int bj = 0; bj < 2; ++bj) { const f32x4 v0 = acc[ai][bj][m][0] * gw, v1 = acc[ai][bj][m][1] * gw;
                    u32x4 w; w.x = cvtpk(v0[0], v0[1]); w.y = cvtpk(v0[2], v0[3]); w.z = cvtpk(v1[0], v1[1]); w.w = cvtpk(v1[2], v1[3]);
                    *(u32x4*)(rowp + bj * 128) = w; } }
    }
};

constexpr int AT_K = 0, AT_KB = 13312, AT_V = 26624, AT_VB = 8192, AT_WS = 43008, AT_OST = 45056, AT_BT = 77824, AT_O1 = 79872;
static_assert(AT_O1 + 8 * 8192 <= RING_BYTES, "attention LDS map");
__device__ __forceinline__ s16x4 vtr(const LAS unsigned char* p) { return __builtin_bit_cast(s16x4, __builtin_amdgcn_ds_read_tr16_b64_v4i16((LAS v4i16_t*)p)); }

__device__ __forceinline__ float max3f(float a, float b, float c) { float r; asm("v_max3_f32 %0, %1, %2, %3" : "=v"(r) : "v"(a), "v"(b), "v"(c)); return r; }
__device__ __forceinline__ float max2f(float a, float b) { float r; asm("v_max_f32_e32 %0, %1, %2" : "=v"(r) : "v"(a), "v"(b)); return r; }
__device__ __forceinline__ void glds16(const char* sbase  , unsigned voff  , unsigned lds_dst) {
    asm volatile("s_mov_b32 m0, %2\n\tglobal_load_lds_dwordx4 %0, %1" :: "v"(voff), "s"(sbase), "s"(lds_dst) : "memory"); }
#define GLDS_COVER() asm volatile("s_nop 4" ::: "memory")
__device__ __forceinline__ void attn_core_na(f32x16 (&o)[2], LAS unsigned char* lds, const bf16_t* Qlane, const bf16_t* Kb, const bf16_t* Vb,
                                             int rlo, int n1, int na_rq, const int tid, const int wid) {
    const int lane = tid & 63, r32 = lane & 31, hi = lane >> 5;
    bf16x8 qr[4];
#pragma unroll
    for (int ks = 0; ks < 4; ++ks) qr[ks] = *(const bf16x8*)(Qlane + ks * 16);
    const unsigned voffK = (unsigned)(lane * LDU + wid * 8) * 2u;
    const unsigned voffV = (unsigned)((16 * (wid & 3) + (lane >> 2)) * LDU + (4 * (wid >> 2) + (lane & 3)) * 8) * 2u;
    const unsigned lds0 = (unsigned)(uintptr_t)lds;
    LAS float* wsf = (LAS float*)(lds + AT_WS) + wid * 64;
    const LAS unsigned char* kb0 = lds + AT_K + hi * 1024 + r32 * 16;
    const LAS unsigned char* vb0 = lds + AT_V + ((lane >> 4) & 1) * 32 + (lane & 3) * 8 + (4 * hi + ((lane & 15) >> 2)) * 64;
    const int na_r0 = na_rq - 4 < 0 ? 0 : (na_rq - 4 > 120 ? 120 : na_rq - 4);
    const int na_cq = 32 * (wid & 1) + r32, na_c0 = na_cq - 8 < 0 ? 0 : (na_cq - 8 > 48 ? 48 : na_cq - 8);
    const int NT = n1 + 4;
#define NA_DMA(j, sl) do { const size_t ro_ = (size_t)((j) < n1 ? rlo + (j) : 128 + (j) - n1) * (64 * LDU * 2); \
        glds16((const char*)Kb + ro_, voffK, (unsigned)__builtin_amdgcn_readfirstlane((int)(lds0 + AT_K + (sl) * AT_KB + wid * 1024))); \
        glds16((const char*)Vb + ro_, voffV, (unsigned)__builtin_amdgcn_readfirstlane((int)(lds0 + AT_V + (sl) * AT_VB + wid * 1024))); } while (0)
#define NA_BAR() do { asm volatile("s_waitcnt vmcnt(0)" ::: "memory"); __syncthreads(); } while (0)
    float m_run = -1e30f;
    f32x16 ol = f32x16{};
    bf16x8 ones = {(short)0x3f80, (short)0x3f80, (short)0x3f80, (short)0x3f80, (short)0x3f80, (short)0x3f80, (short)0x3f80, (short)0x3f80};
    asm volatile("" : "+v"(ones));
    o[0] = f32x16{}; o[1] = f32x16{};
    __syncthreads();
    GLDS_COVER(); NA_DMA(0, 0);
    NA_BAR();
    for (int j = 0; j < NT; ++j) {
        const int bf = j & 1;
        if (j + 1 < NT) NA_DMA(j + 1, bf ^ 1);
        const int tile = j < n1 ? rlo + j : 128 + j - n1;
        const bool active = tile >= 128 || (tile >= na_r0 && tile <= na_r0 + 7);
        if (active) {
            __builtin_amdgcn_iglp_opt(0);
            f32x16 p0 = f32x16{}, p1 = f32x16{};
            const LAS unsigned char* kb = kb0 + bf * AT_KB;
#pragma unroll
            for (int ks = 0; ks < 4; ++ks) {
                const bf16x8 b0 = *(const LAS bf16x8*)(kb + ks * 2048), b1 = *(const LAS bf16x8*)(kb + ks * 2048 + 512);
                p0 = __builtin_amdgcn_mfma_f32_32x32x16_bf16(b0, qr[ks], p0, 0, 0, 0);
                p1 = __builtin_amdgcn_mfma_f32_32x32x16_bf16(b1, qr[ks], p1, 0, 0, 0);
            }
            if (tile < 128) {
                const LAS float* bt = (const LAS float*)(lds + AT_BT) + (tile - na_rq + 7) * 31 + 15 - na_cq;
#pragma unroll
                for (int r = 0; r < 16; ++r) {
                    const int ck0 = crow(r, hi), ck1 = ck0 + 32;
                    const bool v0 = (unsigned)(ck0 - na_c0) < 16u, v1 = (unsigned)(ck1 - na_c0) < 16u;
                    const float b0 = bt[v0 ? ck0 : na_c0], b1 = bt[v1 ? ck1 : na_c0];
                    p0[r] = v0 ? p0[r] + b0 : -1e30f;
                    p1[r] = v1 ? p1[r] + b1 : -1e30f;
                }
            }
            float pm;
            { asm volatile("s_nop 15\n\ts_nop 7" : "+v"(p0), "+v"(p1));
              float a_ = max3f(p0[0], p0[1], p1[0]), b_ = max3f(p0[2], p0[3], p1[1]); a_ = max3f(a_, p1[2], p1[3]);
#pragma unroll
              for (int r = 4; r < 16; r += 4) { a_ = max3f(a_, p0[r], p0[r + 1]); b_ = max3f(b_, p0[r + 2], p0[r + 3]); a_ = max3f(a_, p1[r], p1[r + 1]); b_ = max3f(b_, p1[r + 2], p1[r + 3]); }
              pm = max2f(a_, b_); auto rr = __builtin_amdgcn_permlane32_swap(__float_as_uint(pm), __float_as_uint(pm), false, false); pm = max2f(__uint_as_float(rr[0]), __uint_as_float(rr[1])); }
            if (!__all(pm - m_run <= 11.5f)) {
                const float mn = __builtin_fmaxf(m_run, pm), alpha = __builtin_amdgcn_exp2f(m_run - mn);
                m_run = mn;
                if (hi == 0) wsf[r32] = alpha;
#pragma unroll
                for (int r = 0; r < 16; ++r) { const float a = wsf[crow(r, hi)]; o[0][r] *= a; o[1][r] *= a; ol[r] *= a; }
            }
#pragma unroll
            for (int r = 0; r < 16; ++r) { p0[r] = __builtin_amdgcn_exp2f(p0[r] - m_run); p1[r] = __builtin_amdgcn_exp2f(p1[r] - m_run); }
            bf16x8 pa[4];
            { u32x4 w;
              w.x = cvtpk(p0[0], p0[1]); w.y = cvtpk(p0[2], p0[3]); w.z = cvtpk(p0[4], p0[5]); w.w = cvtpk(p0[6], p0[7]); pa[0] = __builtin_bit_cast(bf16x8, w);
              w.x = cvtpk(p0[8], p0[9]); w.y = cvtpk(p0[10], p0[11]); w.z = cvtpk(p0[12], p0[13]); w.w = cvtpk(p0[14], p0[15]); pa[1] = __builtin_bit_cast(bf16x8, w);
              w.x = cvtpk(p1[0], p1[1]); w.y = cvtpk(p1[2], p1[3]); w.z = cvtpk(p1[4], p1[5]); w.w = cvtpk(p1[6], p1[7]); pa[2] = __builtin_bit_cast(bf16x8, w);
              w.x = cvtpk(p1[8], p1[9]); w.y = cvtpk(p1[10], p1[11]); w.z = cvtpk(p1[12], p1[13]); w.w = cvtpk(p1[14], p1[15]); pa[3] = __builtin_bit_cast(bf16x8, w); }
            const LAS unsigned char* vb = vb0 + bf * AT_VB;
#pragma unroll
            for (int ks = 0; ks < 4; ++ks) {
                ol = __builtin_amdgcn_mfma_f32_32x32x16_bf16(pa[ks], ones, ol, 0, 0, 0);
#pragma unroll
                for (int d0 = 0; d0 < 2; ++d0) {
                    const s16x4 lo = vtr(vb + d0 * 4096 + ks * 1024), hh = vtr(vb + d0 * 4096 + ks * 1024 + 512);
                    const bf16x8 vf = {lo[0], lo[1], lo[2], lo[3], hh[0], hh[1], hh[2], hh[3]};
                    o[d0] = __builtin_amdgcn_mfma_f32_32x32x16_bf16(pa[ks], vf, o[d0], 0, 0, 0);
                }
            }
        }
        NA_BAR();
    }
#undef NA_DMA
#undef NA_BAR
#pragma unroll
    for (int r = 0; r < 16; ++r) { const float rl = __builtin_amdgcn_rcpf(ol[r]); o[0][r] *= rl; o[1][r] *= rl; }
}
template <int DK, bool NEGM = true>
__device__ __forceinline__ void attn_core2(f32x16 (&o)[2], LAS unsigned char* lds, const bf16_t* Qlane, const bf16_t* Kb, const bf16_t* K2b, const bf16_t* Vb,
                                           const int t0, const int NT, const int tid, const int wid) {
    constexpr int NKS = DK / 16;
    constexpr float THR2 = 11.5f;
    const int lane = tid & 63, r32 = lane & 31, hi = lane >> 5;
    bf16x8 qr[NKS];
#pragma unroll
    for (int ks = 0; ks < NKS; ++ks) qr[ks] = *(const bf16x8*)(Qlane + ks * 16);
    const unsigned voffK = (unsigned)(lane * LDU + wid * 8) * 2u;
    const unsigned voffV = (unsigned)((16 * (wid & 3) + (lane >> 2)) * LDU + (4 * (wid >> 2) + (lane & 3)) * 8) * 2u;
    const char* ksrc = (const char*)(Kb + (size_t)t0 * 64 * LDU);
    const char* ksrc2 = (const char*)(K2b + (size_t)t0 * 64 * LDU);
    const char* vsrc = (const char*)(Vb + (size_t)t0 * 64 * LDU);
    const bool kact = DK >= 64 || wid < 4, k2act = DK == 96 && wid < 4;
    LAS float* wsf = (LAS float*)(lds + AT_WS) + wid * 64;
    const LAS unsigned char* kb0 = lds + AT_K + hi * 1024 + r32 * 16;
    const LAS unsigned char* vb0 = lds + AT_V + ((lane >> 4) & 1) * 32 + (lane & 3) * 8 + (4 * hi + ((lane & 15) >> 2)) * 64;
    const unsigned lds0 = (unsigned)(uintptr_t)lds;
#define C2_DMAK(t, sl) do { const size_t ro_ = (size_t)(t) * (64 * LDU * 2); \
        if (kact) glds16(ksrc + ro_, voffK, (unsigned)__builtin_amdgcn_readfirstlane((int)(lds0 + AT_K + (sl) * AT_KB + wid * 1024))); \
        if (k2act) glds16(ksrc2 + ro_, voffK, (unsigned)__builtin_amdgcn_readfirstlane((int)(lds0 + AT_K + (sl) * AT_KB + (8 + wid) * 1024))); } while (0)
#define C2_DMAV(t, sl) do { glds16(vsrc + (size_t)(t) * (64 * LDU * 2), voffV, (unsigned)__builtin_amdgcn_readfirstlane((int)(lds0 + AT_V + (sl) * AT_VB + wid * 1024))); } while (0)
#define C2_BAR() do { asm volatile("s_waitcnt vmcnt(0)" ::: "memory"); __syncthreads(); } while (0)
#define C2_QKT(P0, P1, sl) do { const LAS unsigned char* kb_ = kb0 + (sl) * AT_KB; \
        _Pragma("unroll") for (int ks = 0; ks < NKS; ++ks) { \
            const bf16x8 b0_ = *(const LAS bf16x8*)(kb_ + ks * 2048), b1_ = *(const LAS bf16x8*)(kb_ + ks * 2048 + 512); \
            if (ks == 0) { if constexpr (NEGM) { P0 = __builtin_amdgcn_mfma_f32_32x32x16_bf16(b0_, qr[0], negm, 0, 0, 0); P1 = __builtin_amdgcn_mfma_f32_32x32x16_bf16(b1_, qr[0], negm, 0, 0, 0); } \
                           else { P0 = __builtin_amdgcn_mfma_f32_32x32x16_bf16(b0_, qr[0], f32x16{}, 0, 0, 0); P1 = __builtin_amdgcn_mfma_f32_32x32x16_bf16(b1_, qr[0], f32x16{}, 0, 0, 0); } } \
            else { P0 = __builtin_amdgcn_mfma_f32_32x32x16_bf16(b0_, qr[ks], P0, 0, 0, 0); P1 = __builtin_amdgcn_mfma_f32_32x32x16_bf16(b1_, qr[ks], P1, 0, 0, 0); } } } while (0)
#define C2_FINISH(P0, P1) do { \
        _Pragma("unroll") for (int r = 0; r < 16; ++r) P0[r] = __builtin_amdgcn_exp2f(NEGM ? P0[r] : P0[r] - mhat); \
        _Pragma("unroll") for (int r = 0; r < 16; ++r) P1[r] = __builtin_amdgcn_exp2f(NEGM ? P1[r] : P1[r] - mhat); \
        u32x4 w_; \
        w_.x = cvtpk(P0[0], P0[1]); w_.y = cvtpk(P0[2], P0[3]); w_.z = cvtpk(P0[4], P0[5]); w_.w = cvtpk(P0[6], P0[7]); pa0 = __builtin_bit_cast(bf16x8, w_); \
        w_.x = cvtpk(P0[8], P0[9]); w_.y = cvtpk(P0[10], P0[11]); w_.z = cvtpk(P0[12], P0[13]); w_.w = cvtpk(P0[14], P0[15]); pa1 = __builtin_bit_cast(bf16x8, w_); \
        w_.x = cvtpk(P1[0], P1[1]); w_.y = cvtpk(P1[2], P1[3]); w_.z = cvtpk(P1[4], P1[5]); w_.w = cvtpk(P1[6], P1[7]); pa2 = __builtin_bit_cast(bf16x8, w_); \
        w_.x = cvtpk(P1[8], P1[9]); w_.y = cvtpk(P1[10], P1[11]); w_.z = cvtpk(P1[12], P1[13]); w_.w = cvtpk(P1[14], P1[15]); pa3 = __builtin_bit_cast(bf16x8, w_); } while (0)
#define C2_VFR(d0, ks, L, H) do { L = vtr(vb_ + (d0) * 4096 + (ks) * 1024); H = vtr(vb_ + (d0) * 4096 + (ks) * 1024 + 512); } while (0)
#define C2_VF(L, H) (bf16x8){L[0], L[1], L[2], L[3], H[0], H[1], H[2], H[3]}
  \
#define C2_PV(sl) do { const LAS unsigned char* vb_ = vb0 + (sl) * AT_VB; s16x4 l0_, h0_, l1_, h1_, l2_, h2_, l3_, h3_; \
        C2_VFR(0, 0, l0_, h0_); C2_VFR(1, 0, l1_, h1_); \
        C2_VFR(0, 1, l2_, h2_); C2_VFR(1, 1, l3_, h3_); \
        ol = __builtin_amdgcn_mfma_f32_32x32x16_bf16(pa0, ones, ol, 0, 0, 0); o[0] = __builtin_amdgcn_mfma_f32_32x32x16_bf16(pa0, C2_VF(l0_, h0_), o[0], 0, 0, 0); o[1] = __builtin_amdgcn_mfma_f32_32x32x16_bf16(pa0, C2_VF(l1_, h1_), o[1], 0, 0, 0); \
        C2_VFR(0, 2, l0_, h0_); C2_VFR(1, 2, l1_, h1_); \
        ol = __builtin_amdgcn_mfma_f32_32x32x16_bf16(pa1, ones, ol, 0, 0, 0); o[0] = __builtin_amdgcn_mfma_f32_32x32x16_bf16(pa1, C2_VF(l2_, h2_), o[0], 0, 0, 0); o[1] = __builtin_amdgcn_mfma_f32_32x32x16_bf16(pa1, C2_VF(l3_, h3_), o[1], 0, 0, 0); \
        C2_VFR(0, 3, l2_, h2_); C2_VFR(1, 3, l3_, h3_); \
        ol = __builtin_amdgcn_mfma_f32_32x32x16_bf16(pa2, ones, ol, 0, 0, 0); o[0] = __builtin_amdgcn_mfma_f32_32x32x16_bf16(pa2, C2_VF(l0_, h0_), o[0], 0, 0, 0); o[1] = __builtin_amdgcn_mfma_f32_32x32x16_bf16(pa2, C2_VF(l1_, h1_), o[1], 0, 0, 0); \
        ol = __builtin_amdgcn_mfma_f32_32x32x16_bf16(pa3, ones, ol, 0, 0, 0); o[0] = __builtin_amdgcn_mfma_f32_32x32x16_bf16(pa3, C2_VF(l2_, h2_), o[0], 0, 0, 0); o[1] = __builtin_amdgcn_mfma_f32_32x32x16_bf16(pa3, C2_VF(l3_, h3_), o[1], 0, 0, 0); } while (0)
  \
#define C2_IMAX2(a, b) ((a) > (b) ? (a) : (b))
#define C2_IMAX3(a, b, c) C2_IMAX2(C2_IMAX2((a), (b)), (c))
#define C2_ROWMAXI(P0, P1, rm_) do { \
        int a_ = C2_IMAX3(__float_as_int(P0[0]), __float_as_int(P0[1]), __float_as_int(P1[0])), b_ = C2_IMAX3(__float_as_int(P0[2]), __float_as_int(P0[3]), __float_as_int(P1[1])); a_ = C2_IMAX3(a_, __float_as_int(P1[2]), __float_as_int(P1[3])); \
        _Pragma("unroll") for (int r = 4; r < 16; r += 4) { a_ = C2_IMAX3(a_, __float_as_int(P0[r]), __float_as_int(P0[r + 1])); b_ = C2_IMAX3(b_, __float_as_int(P0[r + 2]), __float_as_int(P0[r + 3])); \
            a_ = C2_IMAX3(a_, __float_as_int(P1[r]), __float_as_int(P1[r + 1])); b_ = C2_IMAX3(b_, __float_as_int(P1[r + 2]), __float_as_int(P1[r + 3])); } \
        a_ = C2_IMAX2(a_, b_); { auto rr_ = __builtin_amdgcn_permlane32_swap((unsigned)a_, (unsigned)a_, false, false); a_ = C2_IMAX2((int)rr_[0], (int)rr_[1]); } rm_ = __int_as_float(a_); } while (0)
#define C2_ROWMAXF(P0, P1, rm_) do { asm volatile("s_nop 15\n\ts_nop 7" : "+v"(P0), "+v"(P1)); \
        float a_ = max3f(P0[0], P0[1], P1[0]), b_ = max3f(P0[2], P0[3], P1[1]); a_ = max3f(a_, P1[2], P1[3]); \
        _Pragma("unroll") for (int r = 4; r < 16; r += 4) { a_ = max3f(a_, P0[r], P0[r + 1]); b_ = max3f(b_, P0[r + 2], P0[r + 3]); a_ = max3f(a_, P1[r], P1[r + 1]); b_ = max3f(b_, P1[r + 2], P1[r + 3]); } \
        rm_ = max2f(a_, b_); { auto rr_ = __builtin_amdgcn_permlane32_swap(__float_as_uint(rm_), __float_as_uint(rm_), false, false); rm_ = max2f(__uint_as_float(rr_[0]), __uint_as_float(rr_[1])); } } while (0)
#define C2_DECIDE(P0, P1) do { float rm_; C2_ROWMAXI(P0, P1, rm_); if constexpr (!NEGM) rm_ -= mhat; \
        if (__builtin_expect(__any(rm_ > THR2), 0)) { const float dl_ = __builtin_fmaxf(rm_, 0.f); mhat += dl_; \
            if constexpr (NEGM) { _Pragma("unroll") for (int r = 0; r < 16; ++r) { P0[r] -= dl_; P1[r] -= dl_; } \
            _Pragma("unroll") for (int r = 0; r < 16; ++r) negm[r] = -mhat; } \
            const float f_ = __builtin_amdgcn_exp2f(-dl_); if (hi == 0) wsf[r32] = f_; \
            _Pragma("unroll") for (int r = 0; r < 16; ++r) { const float a2_ = wsf[crow(r, hi)]; o[0][r] *= a2_; o[1][r] *= a2_; ol[r] *= a2_; } } } while (0)
    float mhat = 0.f;
    f32x16 negm = f32x16{}, pA0, pA1, pB0, pB1, ol = f32x16{};
    bf16x8 pa0, pa1, pa2, pa3;
    bf16x8 ones = {(short)0x3f80, (short)0x3f80, (short)0x3f80, (short)0x3f80, (short)0x3f80, (short)0x3f80, (short)0x3f80, (short)0x3f80};
    asm volatile("" : "+v"(ones));
    o[0] = f32x16{}; o[1] = f32x16{};
    __syncthreads();
    GLDS_COVER(); C2_DMAK(0, 0); C2_DMAV(0, 0); C2_DMAK(1, 1);
    C2_BAR();
    C2_QKT(pA0, pA1, 0);
    { float rm_; C2_ROWMAXF(pA0, pA1, rm_); mhat = rm_;
      if constexpr (NEGM) {
#pragma unroll
      for (int r = 0; r < 16; ++r) { pA0[r] -= rm_; pA1[r] -= rm_; }
#pragma unroll
      for (int r = 0; r < 16; ++r) negm[r] = -mhat; } }
    const int tl = NT - 1;
    for (int j = 0; j < NT; j += 2) {
        C2_BAR();
        __builtin_amdgcn_iglp_opt(0);
        C2_QKT(pB0, pB1, 1);
        C2_FINISH(pA0, pA1);
        C2_DMAK(j + 2 < NT ? j + 2 : tl, 0); C2_DMAV(j + 1, 1);
        C2_PV(0);
        C2_DECIDE(pB0, pB1);
        C2_BAR();
        __builtin_amdgcn_iglp_opt(0);
        C2_QKT(pA0, pA1, 0);
        C2_FINISH(pB0, pB1);
        C2_DMAK(j + 3 < NT ? j + 3 : tl, 1); C2_DMAV(j + 2 < NT ? j + 2 : tl, 0);
        C2_PV(1);
        C2_DECIDE(pA0, pA1);
    }
    asm volatile("s_waitcnt vmcnt(0)" ::: "memory");
#undef C2_DMAK
#undef C2_DMAV
#undef C2_BAR
#undef C2_QKT
#undef C2_FINISH
#undef C2_VFR
#undef C2_VF
#undef C2_PV
#undef C2_IMAX2
#undef C2_IMAX3
#undef C2_ROWMAXI
#undef C2_ROWMAXF
#undef C2_DECIDE
#pragma unroll
    for (int r = 0; r < 16; ++r) { const float rl = __builtin_amdgcn_rcpf(ol[r]); o[0][r] *= rl; o[1][r] *= rl; }
}
__device__ __forceinline__ void attn_store(const f32x16 (&o)[2], LAS unsigned char* lds, bf16_t* Ow, const int lane, const int wid) {
    const int r32 = lane & 31, hi = lane >> 5;
    LAS bf16_t* stg = (LAS bf16_t*)(lds + AT_OST) + wid * 2048;
#pragma unroll
    for (int r = 0; r < 16; ++r) { const int orow = crow(r, hi);
#pragma unroll
        for (int d0 = 0; d0 < 2; ++d0) stg[orow * 64 + d0 * 32 + r32] = (bf16_t)(cvtpk(o[d0][r], 0.f) & 0xffffu); }
    LDS_WAIT();
#pragma unroll
    for (int i = 0; i < 4; ++i) { const int row = i * 8 + (lane >> 3), ch = lane & 7; const u32x4 v = *(const LAS u32x4*)(stg + row * 64 + ch * 8); *(u32x4*)(Ow + (size_t)row * DM + ch * 8) = v; }
    LDS_WAIT();
}

struct AttnCtx { const bf16_t* U; bf16_t* AO; const float* relb; const float* subln; float lam, lam_init; };
template <int kind>
__device__ __forceinline__ void attn_unit(const AttnCtx& A, LAS unsigned char* lds, int b, int h, int qb, const int wv) {
    const int tid = fresh_tid(wv), wid = __builtin_amdgcn_readfirstlane(tid >> 6), lane = tid & 63, r32 = lane & 31, hi = lane >> 5;
    const size_t seg0 = (size_t)b * SEG;
    const size_t qrow = seg0 + (size_t)qb * 256 + wid * 32 + r32;
    const bf16_t* Uq = A.U + qrow * LDU + hi * 8;
    const bf16_t* Us = A.U + seg0 * LDU;
    int orow0 = b * SEG + qb * 256 + wid * 32;
#define AU_OW() ({ asm volatile("" : "+s"(orow0)); A.AO + (size_t)orow0 * DM; })
    const bool isctx = qb == 32;
    const int td0 = isctx ? 128 : 0, tdn = isctx ? 4 : 132;
    f32x16 o[2];
    if constexpr (kind == 0) {
        for (int mp = 0; mp < 2; ++mp) {
            attn_core2<32>(o, lds, Uq + C_Q + (2 * h + mp) * 32, Us + C_K + (2 * h + mp) * 32, Us, Us + C_V + h * 64, td0, tdn, tid, wid);
            if (mp == 0) { LAS float* o1s = (LAS float*)(lds + AT_O1) + wid * 2048 + lane_fresh();
#pragma unroll
                for (int r = 0; r < 16; ++r) { o1s[r * 64] = o[0][r]; o1s[(16 + r) * 64] = o[1][r]; } }
        }
        f32x16 o1[2];
        { const LAS float* o1s = (const LAS float*)(lds + AT_O1) + wid * 2048 + lane_fresh();
#pragma unroll
          for (int r = 0; r < 16; ++r) { o1[0][r] = o1s[r * 64]; o1[1][r] = o1s[(16 + r) * 64]; } }
        const float g0 = A.subln[r32] * (1.f - A.lam_init), g1 = A.subln[32 + r32] * (1.f - A.lam_init);
#pragma unroll
        for (int r = 0; r < 16; ++r) {
            const float d0 = o1[0][r] - A.lam * o[0][r], d1 = o1[1][r] - A.lam * o[1][r];
            float ss = row16_sum(d0 * d0 + d1 * d1);
            { auto p_ = __builtin_amdgcn_permlane16_swap(__float_as_uint(ss), __float_as_uint(ss), false, false); ss = __uint_as_float(p_[0]) + __uint_as_float(p_[1]); }
            const float rs = __builtin_amdgcn_rsqf(ss * (1.f / 64.f) + EPS);
            o[0][r] = d0 * rs * g0; o[1][r] = d1 * rs * g1;
        }
        attn_store(o, lds, AU_OW() + 512 + h * 64, lane, wid);
    } else if constexpr (kind == 1) {
        attn_core2<96>(o, lds, Uq + D_Q + h * 96, Us + D_KN + h * 64, Us + D_KPE, Us + D_V + h * 64, td0, tdn, tid, wid);
        attn_store(o, lds, AU_OW() + 768 + h * 64, lane, wid);
    } else if constexpr (kind == 2) {
        attn_core2<64>(o, lds, Uq + A_Q + h * 64, Us + A_K + (h >> 1) * 64, Us, Us + A_V + (h >> 1) * 64, td0, tdn, tid, wid);
        attn_store(o, lds, AU_OW() + h * 64, lane, wid);
    } else {
        if (isctx) {
            attn_core2<64, false>(o, lds, Uq + B_Q + h * 64, Us + B_K + h * 64, Us, Us + B_V + h * 64, 128, 4, tid, wid);
        } else {
            { LAS float* bt = (LAS float*)(lds + AT_BT); if (tid < 465) bt[tid] = A.relb[h * 465 + tid] * LOG2E; }
            const int ra = 4 * qb - 4 < 0 ? 0 : (4 * qb - 4 > 120 ? 120 : 4 * qb - 4);
            const int rb_ = 4 * qb - 1 < 0 ? 0 : (4 * qb - 1 > 120 ? 120 : 4 * qb - 1);
            attn_core_na(o, lds, Uq + B_Q + h * 64, Us + B_K + h * 64, Us + B_V + h * 64, ra, rb_ + 8 - ra, 4 * qb + (wid >> 1), tid, wid);
        }
        attn_store(o, lds, AU_OW() + 256 + h * 64, lane, wid);
    }
#undef AU_OW
}
template <int kind>
__device__ __forceinline__ void attn_kind_loop(const AttnCtx& A, LAS unsigned char* lds, unsigned* qheads  , int nq, unsigned xcc, const int wv) {
    const int QN = 2 * nq;
    int qoff = 0;
    for (;;) {
        unsigned pop_a = (unsigned)(uintptr_t)(lds + MISC_POP); asm volatile("" : "+v"(pop_a));
        volatile LAS int* pop = (volatile LAS int*)pop_a;
        if (is_t0(wv)) {
            int res = -1;
            while (qoff < 8) {
                const int q = (int)((xcc + qoff) & 7u);
                const unsigned idx = xb_add(qheads + 64 * q, 1u);
                if (idx < (unsigned)QN) { res = q * 65536 + (int)idx; break; }
                ++qoff;
            }
            pop[0] = res;
        }
        __syncthreads();
        const int res = __builtin_amdgcn_readfirstlane(pop[0]);
        __syncthreads();
        if (res < 0) break;
        const int q = res >> 16, idx = res & 0xffff, gi = idx / nq, qb = idx - gi * nq, gk = gi * 8 + q;
        attn_unit<kind>(A, lds, gk >> 2, gk & 3, qb, wv);
    }
}
__device__ __forceinline__ void attn_phase(const AttnCtx& A, LAS unsigned char* lds, unsigned* qheads  , int nq, unsigned xcc, const int wv) {
    attn_kind_loop<0>(A, lds, qheads + 0 * 8 * 64, nq, xcc, wv);
    attn_kind_loop<1>(A, lds, qheads + 1 * 8 * 64, nq, xcc, wv);
    attn_kind_loop<2>(A, lds, qheads + 2 * 8 * 64, nq, xcc, wv);
    attn_kind_loop<3>(A, lds, qheads + 3 * 8 * 64, nq, xcc, wv);
}

struct TItem { const float* W; bf16_t* WT; int K, N, drow0, kb, nb; };
__device__ __forceinline__ void transpose_load(const TItem& d, int lane, float (&tv)[32]) {
    const int k0 = 64 * d.kb, n0 = 32 * d.nb;
#pragma unroll
    for (int i = 0; i < 32; ++i) { const int kk = 2 * i + (lane >> 5); tv[i] = d.W[(size_t)(k0 + kk) * d.N + n0 + (lane & 31)]; }
}
__device__ __forceinline__ void transpose_finish(const TItem& d, const float (&tv)[32], LAS float* scr, int lane) {
    const int k0 = 64 * d.kb;
#pragma unroll
    for (int i = 0; i < 32; ++i) { const int kk = 2 * i + (lane >> 5); scr[kk * 33 + (lane & 31)] = tv[i]; }
    LDS_WAIT(); asm volatile("" ::: "memory");
    const int c = lane & 7;
#pragma unroll
    for (int j = 0; j < 4; ++j) { const int n = (lane >> 3) + 8 * j; const LAS float* s = scr + (8 * c) * 33 + n;
        u32x4 o; o.x = cvtpk(s[0 * 33], s[1 * 33]); o.y = cvtpk(s[2 * 33], s[3 * 33]); o.z = cvtpk(s[4 * 33], s[5 * 33]); o.w = cvtpk(s[6 * 33], s[7 * 33]);
        *(u32x4*)(d.WT + (size_t)(d.drow0 + n) * d.K + k0 + 8 * c) = o; }
    LDS_WAIT(); asm volatile("" ::: "memory");
}
constexpr int WI_IN = 16 * 75, WI_OUT = 16 * 32, WI_GU = 17 * 2 * 16 * 8, WI_DN = 17 * 4 * 32, WI_L = WI_IN + WI_OUT + WI_GU + WI_DN;
__device__ __forceinline__ TItem weight_item(KA a, int it) {
    unsigned char* ws = a->ws; TItem d;
    const int l = it / WI_L; int r = it - l * WI_L;
    if (r < WI_IN) { d.W = a->w_in + (size_t)l * 1024 * INCOLS; d.K = 1024; d.N = INCOLS; d.WT = (bf16_t*)(ws + WS_WINT) + (size_t)l * LDU * 1024; d.drow0 = 32 * (r % 75); d.kb = r / 75; d.nb = r % 75; return d; } r -= WI_IN;
    if (r < WI_OUT) { d.W = a->w_out + (size_t)l * 1024 * 1024; d.K = 1024; d.N = 1024; d.WT = (bf16_t*)(ws + WS_WOUTT) + (size_t)l * 1024 * 1024; d.drow0 = 32 * (r % 32); d.kb = r / 32; d.nb = r % 32; return d; } r -= WI_OUT;
    if (r < WI_GU) { const int e = r / 256, r2 = r % 256, up = r2 >> 7, r3 = r2 & 127; d.kb = r3 >> 3; d.nb = r3 & 7;
        d.W = e < 16 ? (up ? a->wu : a->wg) + ((size_t)l * 16 + e) * 1024 * 256 : (up ? a->su : a->sg) + (size_t)l * 1024 * 256; d.K = 1024; d.N = 256;
        const int n0 = 32 * d.nb; d.WT = (bf16_t*)(ws + WS_WGU) + ((size_t)l * 17 + e) * 512 * 1024; d.drow0 = 256 * (n0 >> 7) + 128 * up + (n0 & 127); return d; } r -= WI_GU;
    { const int e = r / 128, r2 = r % 128; d.kb = r2 >> 5; d.nb = r2 & 31;
        d.W = e < 16 ? a->wd + ((size_t)l * 16 + e) * 256 * 1024 : a->sd + (size_t)l * 256 * 1024; d.K = 256; d.N = 1024; d.WT = (bf16_t*)(ws + WS_WDN) + ((size_t)l * 17 + e) * 1024 * 256; d.drow0 = 32 * d.nb; return d; }
}
__device__ __forceinline__ void prologue(KA a, LAS unsigned char* lds, int G, const int wv) {
    const int tid = fresh_tid(wv), wid = __builtin_amdgcn_readfirstlane(tid >> 6), lane = tid & 63, blk = blockIdx.x;
    unsigned char* ws = a->ws;
    float* MOD = (float*)(ws + WS_MOD);
    bf16_t* WINT = (bf16_t*)(ws + WS_WINT);
#define PRO_PART3() do {   \
        LAS float* scr = (LAS float*)(lds + 16384 + wid * 8704); const int NGW = G * 8; int it = blk * 8 + wid; \
        if (it < 2 * WI_L) { TItem dc = weight_item(a, it); float tv[32]; transpose_load(dc, lane, tv); \
            for (;;) { const int itn = it + NGW; const bool more = itn < 2 * WI_L; TItem dn = dc; float tn[32]; \
                if (more) { dn = weight_item(a, itn); transpose_load(dn, lane, tn); } \
                transpose_finish(dc, tv, scr, lane); \
                if (!more) break; \
                dc = dn; it = itn; _Pragma("unroll") for (int i_ = 0; i_ < 32; ++i_) tv[i_] = tn[i_]; } } \
    } while (0)
    if (blk & 1) { PRO_PART3(); __syncthreads(); }
    {
        LAS float* sil = (LAS float*)lds;
        LAS float* part = (LAS float*)(lds + 20480);
        for (int i = tid; i < 5 * 1024; i += 512) { const int r = i >> 10, k = i & 1023; const float v = r < 4 ? a->c[r * 1024 + k] : a->c_ctx[k]; sil[i] = v / (1.f + __expf(-v)); }
        __syncthreads();
        for (int it = blk; it < 2 * 96; it += G) {
            const int l = it / 96, n0 = (it % 96) * 64;
            const float* wm = a->w_mod + (size_t)l * 1024 * 6144 + n0 + lane;
            float acc[5] = {0.f, 0.f, 0.f, 0.f, 0.f};
#pragma unroll 4
            for (int k = wid * 128; k < wid * 128 + 128; k += 4) {
                const float w0 = wm[(size_t)k * 6144], w1 = wm[(size_t)(k + 1) * 6144], w2 = wm[(size_t)(k + 2) * 6144], w3 = wm[(size_t)(k + 3) * 6144];
#pragma unroll
                for (int r = 0; r < 5; ++r) { const f32x4 s4 = *(const LAS f32x4*)(sil + r * 1024 + k); acc[r] += (s4.x * w0 + s4.y * w1) + (s4.z * w2 + s4.w * w3); } }
#pragma unroll
            for (int r = 0; r < 5; ++r) part[(wid * 5 + r) * 64 + lane] = acc[r];
            __syncthreads();
            if (tid < 320) { const int r = tid >> 6, n = tid & 63; float s = a->b_mod[l * 6144 + n0 + n];
#pragma unroll
                for (int w = 0; w < 8; ++w) s += part[(w * 5 + r) * 64 + n];
                MOD[((size_t)l * 5 + r) * 6144 + n0 + n] = s; }
            __syncthreads();
        }
        if (blk == 0 && tid < 2) {
            const int l = tid; float s1 = 0.f, s2 = 0.f;
            for (int i = 0; i < 32; ++i) { s1 += a->lq1[l * 32 + i] * a->lk1[l * 32 + i]; s2 += a->lq2[l * 32 + i] * a->lk2[l * 32 + i]; }
            const float lam_init = 0.8f - 0.6f * expf(-0.3f * (float)l);
            ((float*)(ws + WS_LAM))[l] = expf(s1) - expf(s2) + lam_init;
        }
        __syncthreads();
    }
    {
        LAS float* aw = (LAS float*)lds;
        for (int it = blk; it < 2 * 128; it += G) {
            const int l = it >> 7, k0 = (it & 127) * 8;
            for (int i = tid; i < 8 * 320; i += 512) { const int kk = i / 320, j = i - kk * 320;
                const float g = j < 192 ? a->mla_qn[l * 192 + j] : a->mla_kvn[l * 128 + (j - 192)];
                aw[i] = a->w_in[((size_t)l * 1024 + k0 + kk) * INCOLS + D_CQ + j] * g; }
            __syncthreads();
            for (int n = tid; n < 896; n += 512) {
                float acc[8] = {0.f, 0.f, 0.f, 0.f, 0.f, 0.f, 0.f, 0.f};
                int drow;
                if (n < 384) {
                    const float* wq = a->mla_wqu + (size_t)l * 192 * 384 + n;
#pragma unroll 4
                    for (int j = 0; j < 192; j += 4) { const float w0 = wq[(size_t)j * 384], w1 = wq[(size_t)(j + 1) * 384], w2 = wq[(size_t)(j + 2) * 384], w3 = wq[(size_t)(j + 3) * 384];
#pragma unroll
                        for (int kk = 0; kk < 8; ++kk) { const f32x4 a4 = *(const LAS f32x4*)(aw + kk * 320 + j); acc[kk] += (a4.x * w0 + a4.y * w1) + (a4.z * w2 + a4.w * w3); } }
                    drow = D_Q + n;
                } else {
                    const int n2 = n - 384; const float* wk = a->mla_wkvu + (size_t)l * 128 * 512 + n2;
#pragma unroll 4
                    for (int j = 0; j < 128; j += 4) { const float w0 = wk[(size_t)j * 512], w1 = wk[(size_t)(j + 1) * 512], w2 = wk[(size_t)(j + 2) * 512], w3 = wk[(size_t)(j + 3) * 512];
#pragma unroll
                        for (int kk = 0; kk < 8; ++kk) { const f32x4 a4 = *(const LAS f32x4*)(aw + kk * 320 + 192 + j); acc[kk] += (a4.x * w0 + a4.y * w1) + (a4.z * w2 + a4.w * w3); } }
                    const int hh = n2 >> 7, cc = n2 & 127;
                    drow = cc < 64 ? D_KN + hh * 64 + cc : D_V + hh * 64 + (cc - 64);
                }
                u32x4 w; w.x = cvtpk(acc[0], acc[1]); w.y = cvtpk(acc[2], acc[3]); w.z = cvtpk(acc[4], acc[5]); w.w = cvtpk(acc[6], acc[7]);
                *(u32x4*)(WINT + ((size_t)l * LDU + drow) * 1024 + k0) = w;
            }
            __syncthreads();
        }
        for (int i = blk * 512 + tid; i < 2 * 32 * 128; i += G * 512) { const int l = i / 4096, r = (i % 4096) / 128, ch = i % 128;
            *(u32x4*)(WINT + ((size_t)l * LDU + U_PAD0 + r) * 1024 + ch * 8) = (u32x4){0u, 0u, 0u, 0u}; }
    }
    if (!(blk & 1)) { __syncthreads(); PRO_PART3(); }
#undef PRO_PART3
}

__device__ __forceinline__ void load_row16(const float* row, int lane, f32x4 (&v)[4]) {
#pragma unroll
    for (int j = 0; j < 4; ++j) v[j] = *(const f32x4*)(row + 4 * lane + 256 * j);
}
__device__ __forceinline__ void load_row16_bf(const bf16_t* row, int lane, f32x4 (&v)[4]) {
#pragma unroll
    for (int j = 0; j < 4; ++j) { const u32x2 w = *(const u32x2*)(row + 4 * lane + 256 * j); v[j] = (f32x4){bf_lo(w.x), bf_hi(w.x), bf_lo(w.y), bf_hi(w.y)}; }
}
__device__ __forceinline__ void store_row16_bf(bf16_t* row, int lane, const f32x4 (&v)[4]) {
#pragma unroll
    for (int j = 0; j < 4; ++j) { u32x2 w; w.x = cvtpk(v[j].x, v[j].y); w.y = cvtpk(v[j].z, v[j].w); *(u32x2*)(row + 4 * lane + 256 * j) = w; }
}
__device__ __forceinline__ float sumsq16(const f32x4 (&v)[4]) {
    float s = 0.f;
#pragma unroll
    for (int j = 0; j < 4; ++j) s += (v[j].x * v[j].x + v[j].y * v[j].y) + (v[j].z * v[j].z + v[j].w * v[j].w);
    return s;
}
struct ModCoef { f32x4 ga[4], gb[4]; int cls; };
__device__ __forceinline__ void modcoef_load(ModCoef& mc, const float* norm, const float* modl  , int cls, int shift_off, int lane) {
    mc.cls = cls;
#pragma unroll
    for (int j = 0; j < 4; ++j) { const int c = 4 * lane + 256 * j; const f32x4 g = *(const f32x4*)(norm + c), sh = *(const f32x4*)(modl + cls * 6144 + shift_off + c), sc = *(const f32x4*)(modl + cls * 6144 + shift_off + 1024 + c);
        mc.ga[j] = g * (sc + 1.f); mc.gb[j] = sh; }
}
__device__ __forceinline__ void store_h16(bf16_t* hrow, int lane, const f32x4 (&v)[4], float rstd, const ModCoef& mc) {
#pragma unroll
    for (int j = 0; j < 4; ++j) { const f32x4 y = v[j] * rstd * mc.ga[j] + mc.gb[j]; u32x2 w; w.x = cvtpk(y.x, y.y); w.y = cvtpk(y.z, y.w); *(u32x2*)(hrow + 4 * lane + 256 * j) = w; }
}
__device__ __forceinline__ void wave_rows(int ch, int wid, int& rbeg, int& nrow) { rbeg = ch * 132 + wid * 16 + (wid < 4 ? wid : 4); nrow = 16 + (wid < 4 ? 1 : 0); }
__device__ __forceinline__ void phase_norm1(KA a, int G, const int wv) {
    const int tid = fresh_tid(wv), wid = __builtin_amdgcn_readfirstlane(tid >> 6), lane = tid & 63;
    const float* modl = (const float*)(a->ws + WS_MOD); bf16_t* H = (bf16_t*)(a->ws + WS_H);
    const float* XL = a->x; const float* XC = a->ctx;
    ModCoef mc; mc.cls = -1;
    for (int ch = blockIdx.x; ch < 256; ch += G) {
        int rbeg, nrow; wave_rows(ch, wid, rbeg, nrow);
        f32x4 vn[2][4];
        load_row16(xrow_in(XL, XC, rbeg), lane, vn[0]); load_row16(xrow_in(XL, XC, rbeg + 1), lane, vn[1]);
        for (int i = 0; i < nrow; i += 2) {
            f32x4 v[2][4];
#pragma unroll
            for (int k = 0; k < 2; ++k)
#pragma unroll
                for (int j = 0; j < 4; ++j) v[k][j] = vn[k][j];
            if (i + 2 < nrow) { load_row16(xrow_in(XL, XC, rbeg + i + 2), lane, vn[0]); load_row16(xrow_in(XL, XC, rbeg + (i + 3 < nrow ? i + 3 : nrow - 1)), lane, vn[1]); }
#pragma unroll
            for (int k = 0; k < 2; ++k) if (i + k < nrow) {
                const int R = rbeg + i + k, b = R / SEG, t = R - b * SEG, cls = t < SEQ ? b : 4;
                if (cls != mc.cls) modcoef_load(mc, a->norm_mix, modl, cls, 0, lane);
                const float rstd = __builtin_amdgcn_rsqf(wave_sum(sumsq16(v[k])) * (1.f / 1024.f) + EPS);
                store_h16(H + (size_t)R * DM, lane, v[k], rstd, mc);
            }
        }
    }
}

template <bool DRY = false>
__device__ __forceinline__ void phase_post(KA a, LAS unsigned char* lds, int l, int G, const int wv) {
    const int tid = fresh_tid(wv), wid = __builtin_amdgcn_readfirstlane(tid >> 6), lane = tid & 63;
    LAS f32x2* T64 = (LAS f32x2*)lds;
    LAS f32x2* T32 = (LAS f32x2*)(lds + 16384);
    for (int i = tid; i < 2048; i += 512) { const int pos = i >> 4, k = i & 15; const float ang = (float)pos * powf(10000.f, -(float)k / 16.f); float s, c; sincosf(ang, &s, &c); T64[i] = (f32x2){c, s}; }
    for (int i = tid; i < 1024; i += 512) { const int pos = i >> 3, k = i & 7; const float ang = (float)pos * powf(10000.f, -(float)k / 8.f); float s, c; sincosf(ang, &s, &c); T32[i] = (f32x2){c, s}; }
    __syncthreads();
    bf16_t* U = (bf16_t*)(a->ws + WS_U);
    const float* qg = a->gqa_qn + l * 64; const float* kg = a->gqa_kn + l * 64;
    const int j16 = lane & 15;
    f32x4 gq, gk; { const int d = 4 * j16; gq = *(const f32x4*)(qg + d) * QS64; gk = *(const f32x4*)(kg + d); }
    struct PostIn { u32x2 wq, wk, cq, ck; unsigned w0, w1, w2, dq[4], kpe; u32x4 kn; };
#define POST_LOAD(in_, R_) do { const bf16_t* u_ = U + (size_t)(R_) * LDU; \
        in_.wq = *(const u32x2*)(u_ + A_Q + 4 * lane); in_.wk = *(const u32x2*)(u_ + A_K + 4 * (lane & 31)); \
        in_.cq = *(const u32x2*)(u_ + C_Q + 4 * lane); in_.ck = *(const u32x2*)(u_ + C_K + 4 * lane); \
        in_.w0 = *(const unsigned*)(u_ + D_CQ + 2 * lane); in_.w1 = *(const unsigned*)(u_ + D_CQ + 128 + 2 * (lane & 31)); in_.w2 = *(const unsigned*)(u_ + D_CKV + 2 * lane); \
        _Pragma("unroll") for (int hh_ = 0; hh_ < 4; ++hh_) in_.dq[hh_] = *(const unsigned*)(u_ + D_Q + hh_ * 96 + 2 * lane); \
        in_.kpe = *(const unsigned*)(u_ + D_KPE + 2 * (lane & 15)); in_.kn = *(const u32x4*)(u_ + D_KN + 8 * lane); } while (0)
    for (int ch = blockIdx.x; ch < 256; ch += G) {
        PostIn nx; POST_LOAD(nx, ch * 132 + wid);
        for (int rr = wid; rr < 132; rr += 8) {
            const int R = ch * 132 + rr, b = R / SEG, t = R - b * SEG; const bool lat = t < SEQ; const int gr = t >> 6, gc = t & 63;
            bf16_t* u = U + (size_t)R * LDU;
            const ptrdiff_t dso = DRY ? ((char*)((bf16_t*)(a->ws + WS_DRY) + (size_t)(R & 1023) * LDU) - (char*)u) : 0;
            const PostIn in = nx;
            if (rr + 8 < 132) POST_LOAD(nx, R + 8);
            {
                const u32x2 wq = in.wq; const u32x2 wk = in.wk;
                f32x4 xq = {bf_lo(wq.x), bf_hi(wq.x), bf_lo(wq.y), bf_hi(wq.y)}, xk = {bf_lo(wk.x), bf_hi(wk.x), bf_lo(wk.y), bf_hi(wk.y)};
                float sq = (xq.x * xq.x + xq.y * xq.y) + (xq.z * xq.z + xq.w * xq.w), sk = (xk.x * xk.x + xk.y * xk.y) + (xk.z * xk.z + xk.w * xk.w);
                sq = row16_sum(sq); sk = row16_sum(sk);
                xq = xq * __builtin_amdgcn_rsqf(sq * (1.f / 64.f) + EPS) * gq; xk = xk * __builtin_amdgcn_rsqf(sk * (1.f / 64.f) + EPS) * gk;
                f32x4 pq, pk;
#pragma unroll
                for (int e = 0; e < 4; ++e) { pq[e] = lane_xor4(xq[e]); pk[e] = lane_xor4(xk[e]); }
                if (lat) {
                    const int jj = j16 & 7, pos = (j16 >> 3) ? gc : gr; const bool x2 = jj >= 4; const int i0 = 4 * (jj & 3);
#pragma unroll
                    for (int e = 0; e < 4; ++e) { const f32x2 cs = T64[pos * 16 + i0 + e];
                        xq[e] = x2 ? pq[e] * cs.y + xq[e] * cs.x : xq[e] * cs.x - pq[e] * cs.y;
                        xk[e] = x2 ? pk[e] * cs.y + xk[e] * cs.x : xk[e] * cs.x - pk[e] * cs.y; }
                }
                u32x2 o; o.x = cvtpk(xq.x, xq.y); o.y = cvtpk(xq.z, xq.w); *(u32x2*)((char*)(u + A_Q + 4 * lane) + dso) = o;
                if (lane < 32) { o.x = cvtpk(xk.x, xk.y); o.y = cvtpk(xk.z, xk.w); *(u32x2*)((char*)(u + A_K + 4 * lane) + dso) = o; }
            }
            if (lat) {
                const int jj = lane & 7, pos = (jj >> 2) ? gc : gr; const bool x2 = (jj >> 1) & 1; const int i0 = 4 * (jj & 1);
#pragma unroll
                for (int qk = 0; qk < 2; ++qk) {
                    bf16_t* p = u + (qk ? C_K : C_Q) + 4 * lane;
                    const u32x2 w = qk ? in.ck : in.cq; f32x4 x = {bf_lo(w.x), bf_hi(w.x), bf_lo(w.y), bf_hi(w.y)}, pp;
#pragma unroll
                    for (int e = 0; e < 4; ++e) pp[e] = lane_xor2(x[e]);
#pragma unroll
                    for (int e = 0; e < 4; ++e) { const f32x2 cs = T32[pos * 8 + i0 + e]; x[e] = x2 ? pp[e] * cs.y + x[e] * cs.x : x[e] * cs.x - pp[e] * cs.y; }
                    u32x2 o; o.x = cvtpk(x.x, x.y); o.y = cvtpk(x.z, x.w); *(u32x2*)((char*)p + dso) = o;
                }
            }
            {
                const unsigned w0 = in.w0, w1 = in.w1, w2 = in.w2;
                float sq = bf_lo(w0) * bf_lo(w0) + bf_hi(w0) * bf_hi(w0); if (lane < 32) sq += bf_lo(w1) * bf_lo(w1) + bf_hi(w1) * bf_hi(w1);
                float sk = bf_lo(w2) * bf_lo(w2) + bf_hi(w2) * bf_hi(w2);
                const float rq = __builtin_amdgcn_rsqf(wave_sum(sq) * (1.f / 192.f) + EPS), rk = __builtin_amdgcn_rsqf(wave_sum(sk) * (1.f / 128.f) + EPS);
                const int lp = lane & 15, pj = lp >> 2; const bool px2 = pj & 1; const int ppos = (pj >> 1) ? gc : gr, pi0 = 2 * (lp & 3);
#pragma unroll
                for (int hh = 0; hh < 4; ++hh) {
                    bf16_t* p = u + D_Q + hh * 96 + 2 * lane;
                    const unsigned w = in.dq[hh]; float x0 = bf_lo(w) * (rq * QS96), x1 = bf_hi(w) * (rq * QS96);
                    const float y0 = lane_xor4(x0), y1 = lane_xor4(x1);
                    if (lat && lane >= 32) { const f32x2 c0 = T32[ppos * 8 + pi0], c1 = T32[ppos * 8 + pi0 + 1];
                        x0 = px2 ? y0 * c0.y + x0 * c0.x : x0 * c0.x - y0 * c0.y; x1 = px2 ? y1 * c1.y + x1 * c1.x : x1 * c1.x - y1 * c1.y; }
                    if (lane < 48) *(unsigned*)((char*)p + dso) = cvtpk(x0, x1);
                }
                {
                    bf16_t* p = u + D_KPE + 2 * (lane & 15);
                    const unsigned w = in.kpe; float x0 = bf_lo(w), x1 = bf_hi(w);
                    const float y0 = lane_xor4(x0), y1 = lane_xor4(x1);
                    if (lat) { const f32x2 c0 = T32[ppos * 8 + pi0], c1 = T32[ppos * 8 + pi0 + 1];
                        x0 = px2 ? y0 * c0.y + x0 * c0.x : x0 * c0.x - y0 * c0.y; x1 = px2 ? y1 * c1.y + x1 * c1.x : x1 * c1.x - y1 * c1.y; }
                    if (lat && lane < 16) *(unsigned*)((char*)p + dso) = cvtpk(x0, x1);
                }
                {
                    bf16_t* p = u + D_KN + 8 * lane; const u32x4 w = in.kn; u32x4 o;
                    o.x = cvtpk(bf_lo(w.x) * rk, bf_hi(w.x) * rk); o.y = cvtpk(bf_lo(w.y) * rk, bf_hi(w.y) * rk); o.z = cvtpk(bf_lo(w.z) * rk, bf_hi(w.z) * rk); o.w = cvtpk(bf_lo(w.w) * rk, bf_hi(w.w) * rk);
                    *(u32x4*)((char*)p + dso) = o;
                }
            }
        }
    }
#undef POST_LOAD
}

__device__ __forceinline__ float route_reduce(const float (&s16)[16], const bool b3, const bool b2) {
    float s8[8], s4[4], s2[2], s1;
#pragma unroll
    for (int e = 0; e < 8; ++e) { auto p = __builtin_amdgcn_permlane32_swap(__float_as_uint(s16[e]), __float_as_uint(s16[8 + e]), false, false); s8[e] = __uint_as_float(p[0]) + __uint_as_float(p[1]); }
#pragma unroll
    for (int e = 0; e < 4; ++e) { auto p = __builtin_amdgcn_permlane16_swap(__float_as_uint(s8[e]), __float_as_uint(s8[4 + e]), false, false); s4[e] = __uint_as_float(p[0]) + __uint_as_float(p[1]); }
#pragma unroll
    for (int e = 0; e < 2; ++e) { const float keep = b3 ? s4[2 + e] : s4[e], send = b3 ? s4[e] : s4[2 + e];
        s2[e] = keep + __int_as_float(__builtin_amdgcn_update_dpp(0, __float_as_int(send), 0x128, 0xf, 0xf, true)); }
    { const float keep = b2 ? s2[1] : s2[0], send = b2 ? s2[0] : s2[1];
      s1 = keep + lane_xor4(send); }
    s1 += __int_as_float(__builtin_amdgcn_update_dpp(0, __float_as_int(s1), 0x4E, 0xf, 0xf, true));
    s1 += __int_as_float(__builtin_amdgcn_update_dpp(0, __float_as_int(s1), 0xB1, 0xf, 0xf, true));
    return s1;
}
__device__ __forceinline__ void route_select(const float s1, const float rbl, const int lane, unsigned& epair, float& wn0, float& wn1) {
    const float sig = 1.f / (1.f + __expf(-s1));
    const float sv = sig + rbl;
    float m1 = __builtin_fmaxf(sv, DPPF(sv, 0x141)); m1 = __builtin_fmaxf(m1, DPPF(m1, 0x140));
    const unsigned long long bm1 = __ballot(sv == m1);
    const int f1 = __builtin_ctz((unsigned)(bm1 >> (lane & 48)) & 0xffffu) >> 2;
    const float sv2 = ((lane & 15) >> 2) == f1 ? -1e30f : sv;
    float m2 = __builtin_fmaxf(sv2, DPPF(sv2, 0x141)); m2 = __builtin_fmaxf(m2, DPPF(m2, 0x140));
    const unsigned long long bm2 = __ballot(sv2 == m2);
    const int f2 = __builtin_ctz((unsigned)(bm2 >> (lane & 48)) & 0xffffu) >> 2;
    const float gsum = m1 + m2;
    const float g0 = __uint_as_float(__builtin_amdgcn_readlane(__float_as_uint(gsum), 0)), g1 = __uint_as_float(__builtin_amdgcn_readlane(__float_as_uint(gsum), 16)),
                g2 = __uint_as_float(__builtin_amdgcn_readlane(__float_as_uint(gsum), 32)), g3 = __uint_as_float(__builtin_amdgcn_readlane(__float_as_uint(gsum), 48));
    int bg = 0; float bgs = g0; if (g1 > bgs) { bgs = g1; bg = 1; } if (g2 > bgs) { bgs = g2; bg = 2; } if (g3 > bgs) { bgs = g3; bg = 3; }
    const int bl = __builtin_amdgcn_readfirstlane(bg) * 16;
    const int e0 = (bl >> 2) + __builtin_amdgcn_readlane(f1, bl), e1 = (bl >> 2) + __builtin_amdgcn_readlane(f2, bl);
    const float w0 = __uint_as_float(__builtin_amdgcn_readlane(__float_as_uint(sig), 4 * e0)), w1 = __uint_as_float(__builtin_amdgcn_readlane(__float_as_uint(sig), 4 * e1));
    const float inv = 1.f / (w0 + w1);
    epair = (unsigned)e0 | ((unsigned)e1 << 8); wn0 = w0 * inv; wn1 = w1 * inv;
}
template <bool DRY = false>
__device__ __forceinline__ void phase_route(KA a, LAS unsigned char* lds, int l, int G, const int wv) {
    const int tid = fresh_tid(wv), wid = __builtin_amdgcn_readfirstlane(tid >> 6), lane = tid & 63;
    unsigned char* ws = a->ws;
    const float* modl = (const float*)(ws + WS_MOD) + (size_t)l * 5 * 6144; bf16_t* H = (bf16_t*)(ws + WS_H);
    const bf16_t* X1 = (const bf16_t*)(ws + WS_X1);
    unsigned* ecnt = (unsigned*)(ws + WS_CTL) + CW_ECNT + l * 16 * 64;
    unsigned* LIST = (unsigned*)(ws + WS_LIST); float* WL = (float*)(ws + WS_WL); unsigned* RSLOT = (unsigned*)(ws + WS_RSLOT);
    LAS float* rwT = (LAS float*)lds;
    LAS unsigned* RE = (LAS unsigned*)(lds + 65536);
    LAS float* RW0 = (LAS float*)(lds + 65536 + 1024);
    LAS float* RW1 = (LAS float*)(lds + 65536 + 2048);
    for (int i = tid; i < 16384; i += 512) { const int k = i >> 4, e = i & 15; rwT[e * 1024 + k] = a->router_w[i]; }
    LAS float* GAB = (LAS float*)(lds + 69632);
    for (int i = tid; i < 5 * 1024; i += 512) { const int c5 = i >> 10, k = i & 1023; const float g = a->norm_ffn[l * 1024 + k], sh = modl[c5 * 6144 + 3072 + k], sc = modl[c5 * 6144 + 3072 + 1024 + k];
        GAB[c5 * 2048 + k] = g * (sc + 1.f); GAB[c5 * 2048 + 1024 + k] = sh; }
    __syncthreads();
    const float rbl = a->router_b[lane >> 2];
    const bool b3 = lane & 8, b2 = lane & 4;
    for (int ch = blockIdx.x; ch < 256; ch += G) {
        int rbeg, nrow; wave_rows(ch, wid, rbeg, nrow);
        f32x4 vnA[4], vnB[4];
        load_row16_bf(X1 + (size_t)rbeg * DM, lane, vnA); load_row16_bf(X1 + (size_t)(rbeg + 1) * DM, lane, vnB);
        for (int i = 0; i < nrow; i += 2) {
            f32x4 vA[4], vB[4];
#pragma unroll
            for (int j = 0; j < 4; ++j) { vA[j] = vnA[j]; vB[j] = vnB[j]; }
            const int iB = i + 1 < nrow ? i + 1 : i;
            if (i + 2 < nrow) { load_row16_bf(X1 + (size_t)(rbeg + i + 2) * DM, lane, vnA); load_row16_bf(X1 + (size_t)(rbeg + (i + 3 < nrow ? i + 3 : i + 2)) * DM, lane, vnB); }
            const int RA = rbeg + i, RB = rbeg + iB, rrA = RA - ch * 132, rrB = RB - ch * 132;
            const int bA = RA / SEG, tA = RA - bA * SEG, clsA = tA < SEQ ? bA : 4, bB = RB / SEG, tB = RB - bB * SEG, clsB = tB < SEQ ? bB : 4;
            const bool skipA = l == 1 && clsA == 4, skipB = l == 1 && clsB == 4;
            const float rstdA = __builtin_amdgcn_rsqf(wave_sum(sumsq16(vA)) * (1.f / 1024.f) + EPS), rstdB = __builtin_amdgcn_rsqf(wave_sum(sumsq16(vB)) * (1.f / 1024.f) + EPS);
            f32x4 hA[4], hB[4];
#pragma unroll
            for (int j = 0; j < 4; ++j) { const LAS float* gA = GAB + clsA * 2048 + 4 * lane + 256 * j; const LAS float* gB = GAB + clsB * 2048 + 4 * lane + 256 * j;
                hA[j] = vA[j] * rstdA * *(const LAS f32x4*)gA + *(const LAS f32x4*)(gA + 1024); hB[j] = vB[j] * rstdB * *(const LAS f32x4*)gB + *(const LAS f32x4*)(gB + 1024); }
            { bf16_t* hrA = DRY ? (bf16_t*)(ws + WS_DRY) + (size_t)(RA & 1023) * DM : H + (size_t)RA * DM; bf16_t* hrB = DRY ? (bf16_t*)(ws + WS_DRY) + (size_t)(RB & 1023) * DM : H + (size_t)RB * DM;
#pragma unroll
              for (int j = 0; j < 4; ++j) { u32x2 w; w.x = cvtpk(hA[j].x, hA[j].y); w.y = cvtpk(hA[j].z, hA[j].w); *(u32x2*)(hrA + 4 * lane + 256 * j) = w;
                                            w.x = cvtpk(hB[j].x, hB[j].y); w.y = cvtpk(hB[j].z, hB[j].w); *(u32x2*)(hrB + 4 * lane + 256 * j) = w; } }
            float sA[16], sB[16];
            f32x4 wb[2][2][4];
#pragma unroll
            for (int q = 0; q < 2; ++q)
#pragma unroll
                for (int j = 0; j < 4; ++j) wb[0][q][j] = *(const LAS f32x4*)(rwT + q * 1024 + 4 * lane + 256 * j);
#pragma unroll
            for (int e2 = 0; e2 < 16; e2 += 2) {
                const int cb = (e2 >> 1) & 1;
                if (e2 + 2 < 16) {
#pragma unroll
                    for (int q = 0; q < 2; ++q)
#pragma unroll
                        for (int j = 0; j < 4; ++j) wb[cb ^ 1][q][j] = *(const LAS f32x4*)(rwT + (e2 + 2 + q) * 1024 + 4 * lane + 256 * j); }
                __builtin_amdgcn_sched_barrier(0);
                { f32x2 aA[2][2] = {{{0.f, 0.f}, {0.f, 0.f}}, {{0.f, 0.f}, {0.f, 0.f}}}, aB[2][2] = {{{0.f, 0.f}, {0.f, 0.f}}, {{0.f, 0.f}, {0.f, 0.f}}};
#pragma unroll
                  for (int j = 0; j < 4; ++j)
#pragma unroll
                      for (int q = 0; q < 2; ++q) { const f32x4 w = wb[cb][q][j]; const f32x2 wlo = {w.x, w.y}, whi = {w.z, w.w};
                          aA[q][0] = (f32x2){hA[j].x, hA[j].y} * wlo + aA[q][0]; aA[q][1] = (f32x2){hA[j].z, hA[j].w} * whi + aA[q][1];
                          aB[q][0] = (f32x2){hB[j].x, hB[j].y} * wlo + aB[q][0]; aB[q][1] = (f32x2){hB[j].z, hB[j].w} * whi + aB[q][1]; }
#pragma unroll
                  for (int q = 0; q < 2; ++q) { const f32x2 tA2 = aA[q][0] + aA[q][1], tB2 = aB[q][0] + aB[q][1]; sA[e2 + q] = tA2.x + tA2.y; sB[e2 + q] = tB2.x + tB2.y; } }
                __builtin_amdgcn_sched_barrier(0); }
            const float s1A = route_reduce(sA, b3, b2), s1B = route_reduce(sB, b3, b2);
            unsigned epA, epB; float wA0, wA1, wB0, wB1;
            route_select(s1A, rbl, lane, epA, wA0, wA1); route_select(s1B, rbl, lane, epB, wB0, wB1);
            if (lane == 0) { RE[rrA] = skipA ? 0xffffu : epA; RW0[rrA] = wA0; RW1[rrA] = wA1; RE[rrB] = skipB ? 0xffffu : epB; RW0[rrB] = wB0; RW1[rrB] = wB1; }
        }
        __syncthreads();
        if (!DRY) {
            LAS unsigned* CNT = (LAS unsigned*)(lds + 65536 + 3072);
            LAS unsigned* BAS = (LAS unsigned*)(lds + 65536 + 3136);
            if (tid < 16) CNT[tid] = 0u;
            __syncthreads();
            unsigned e_me = 0xffu, li = 0u; int rr_me = 0, sl_me = 0;
            if (tid < 264) { rr_me = tid >> 1; sl_me = tid & 1; const unsigned re = RE[rr_me];
                if (re != 0xffffu) { e_me = sl_me ? (re >> 8) : (re & 0xffu); li = __hip_atomic_fetch_add(CNT + e_me, 1u, __ATOMIC_RELAXED, __HIP_MEMORY_SCOPE_WORKGROUP); } }
            __syncthreads();
            if (tid < 16) { const unsigned n = CNT[tid]; BAS[tid] = n ? xb_add(ecnt + 64 * tid, n) : 0u; }
            __syncthreads();
            if (e_me != 0xffu) { const unsigned pos = BAS[e_me] + li; const int R = ch * 132 + rr_me;
                LIST[(size_t)e_me * MROWS + pos] = (unsigned)R; WL[(size_t)e_me * MROWS + pos] = sl_me ? RW1[rr_me] : RW0[rr_me]; RSLOT[2 * R + sl_me] = (e_me << 16) | pos; }
        }
        __syncthreads();
    }
}
__device__ __forceinline__ int moe_tables(KA a, LAS unsigned char* lds, int l, const int wv) {
    LAS int* tb = (LAS int*)(lds + MISC_TB); LAS int* cn = tb + 32; LAS int* t2e = (LAS int*)(lds + MISC_T2E);
    unsigned* ecnt = (unsigned*)(a->ws + WS_CTL) + CW_ECNT + l * 16 * 64;
    if (wv == 0) { const int ln = lane_fresh(); if (ln < 16) cn[ln] = (int)xb_ld(ecnt + 64 * ln); }
    __syncthreads();
    if (is_t0(wv)) { int acc = 0; for (int e = 0; e < 16; ++e) { const int c = cn[e]; tb[e] = acc; const int nt = (c + 255) >> 8; for (int i = 0; i < nt; ++i) t2e[acc + i] = e; acc += nt; } tb[16] = acc; }
    __syncthreads();
    return tb[16];
}
template <bool DRY = false>
__device__ __forceinline__ void phase_combine(KA a, LAS unsigned char* lds, int l, int G, const int wv) {
    const int tid = fresh_tid(wv), wid = __builtin_amdgcn_readfirstlane(tid >> 6), lane = tid & 63;
    unsigned char* ws = a->ws;
    const float* MODb = (const float*)(ws + WS_MOD); const float* modl = MODb + (size_t)l * 5 * 6144;
    bf16_t* H = (bf16_t*)(ws + WS_H); const bf16_t* Y = (const bf16_t*)(ws + WS_U); const unsigned* RSLOT = (const unsigned*)(ws + WS_RSLOT);
    bf16_t* X1 = (bf16_t*)(ws + WS_X1); float* OUT = a->out;
    const LAS int* tb = (const LAS int*)(lds + MISC_TB);
    ModCoef mc; mc.cls = -1; f32x4 g2[4], fn[4]; int gcls = -1;
#pragma unroll
    for (int j = 0; j < 4; ++j) fn[j] = *(const f32x4*)(a->final_norm + 4 * lane + 256 * j);
    for (int ch = blockIdx.x; ch < 256; ch += G) {
        int rbeg, nrow; wave_rows(ch, wid, rbeg, nrow);
        if (l == 1) { const int b = rbeg / SEG, t = rbeg - b * SEG; if (t >= SEQ) continue; if (t + nrow > SEQ) nrow = SEQ - t; }
        f32x4 xn[4]; u32x2 yn[3][4]; unsigned sn0, sn1;
#define CB_LOADS(R_) do { sn0 = RSLOT[2 * (R_)]; sn1 = RSLOT[2 * (R_) + 1]; } while (0)
#define CB_LOADD(R_) do { const size_t r0_ = (size_t)(256 * tb[sn0 >> 16]) + (sn0 & 0xffffu), r1_ = (size_t)(256 * tb[sn1 >> 16]) + (sn1 & 0xffffu), r2_ = (size_t)SH_OFF + (R_); \
            load_row16_bf(X1 + (size_t)(R_) * DM, lane, xn); \
            _Pragma("unroll") for (int j = 0; j < 4; ++j) { const int c_ = 4 * lane + 256 * j; yn[0][j] = *(const u32x2*)(Y + r0_ * 1024 + c_); yn[1][j] = *(const u32x2*)(Y + r1_ * 1024 + c_); yn[2][j] = *(const u32x2*)(Y + r2_ * 1024 + c_); } } while (0)
        CB_LOADS(rbeg); CB_LOADD(rbeg); if (nrow > 1) CB_LOADS(rbeg + 1);
        for (int i = 0; i < nrow; ++i) {
            f32x4 v[4]; u32x2 y[3][4];
#pragma unroll
            for (int j = 0; j < 4; ++j) { v[j] = xn[j]; y[0][j] = yn[0][j]; y[1][j] = yn[1][j]; y[2][j] = yn[2][j]; }
            if (i + 1 < nrow) CB_LOADD(rbeg + i + 1);
            if (i + 2 < nrow) CB_LOADS(rbeg + i + 2);
            const int R = rbeg + i, b = R / SEG, t = R - b * SEG, cls = t < SEQ ? b : 4;
            if (cls != gcls) { gcls = cls;
#pragma unroll
                for (int j = 0; j < 4; ++j) g2[j] = *(const f32x4*)(modl + cls * 6144 + 5120 + 4 * lane + 256 * j); }
#pragma unroll
            for (int j = 0; j < 4; ++j) { const u32x2 y0 = y[0][j], y1 = y[1][j], y2 = y[2][j];
                const f32x4 ys = {bf_lo(y0.x) + bf_lo(y1.x) + bf_lo(y2.x), bf_hi(y0.x) + bf_hi(y1.x) + bf_hi(y2.x), bf_lo(y0.y) + bf_lo(y1.y) + bf_lo(y2.y), bf_hi(y0.y) + bf_hi(y1.y) + bf_hi(y2.y)};
                v[j] = v[j] + g2[j] * ys; }
            const float rstd = __builtin_amdgcn_rsqf(wave_sum(sumsq16(v)) * (1.f / 1024.f) + EPS);
            if (l == 0) {
                store_row16_bf(DRY ? (bf16_t*)(ws + WS_DRY) + (size_t)(R & 1023) * DM : X1 + (size_t)R * DM, lane, v);
                if (cls != mc.cls) modcoef_load(mc, a->norm_mix + 1024, MODb + (size_t)5 * 6144, cls, 0, lane);
                store_h16(DRY ? (bf16_t*)(ws + WS_DRY + 8 * MiB) + (size_t)(R & 1023) * DM : H + (size_t)R * DM, lane, v, rstd, mc);
            } else {
                float* xr = DRY ? (float*)(ws + WS_DRY) + (size_t)(R & 1023) * DM : OUT + ((size_t)b * SEQ + t) * DM;
#pragma unroll
                for (int j = 0; j < 4; ++j) *(f32x4*)(xr + 4 * lane + 256 * j) = v[j] * rstd * fn[j];
            }
        }
#undef CB_LOADS
#undef CB_LOADD
    }
}

#ifndef PHASE_MASK
#define PHASE_MASK 0xFFFF
#endif
#define PH(k) ((PHASE_MASK >> (k)) & 1)
#ifndef REPEAT_MASK
#define REPEAT_MASK 0
#endif
#define RP(k) (1 + ((REPEAT_MASK >> (k)) & 1))
#define GRID_BAR() do { asm volatile("" : "+s"(bar.bar)); xcd_barrier(bar, wv); } while (0)
template <int l>
__device__ __forceinline__ void layer_body(KA a0, LAS unsigned char* lds, const int G, XcdBarrier& bar, const int wv) {
#define LB_PTRS() KA a = fresh_args(); unsigned char* ws = a->ws; unsigned* ctl = (unsigned*)(ws + WS_CTL); bf16_t* H = (bf16_t*)(ws + WS_H); bf16_t* U = (bf16_t*)(ws + WS_U); bf16_t* ACT = (bf16_t*)(ws + WS_ACT); \
    float* XC = (float*)(ws + WS_XC); const float* MODb = (const float*)(ws + WS_MOD); (void)ctl; (void)H; (void)U; (void)ACT; (void)XC; (void)MODb; (void)a0

        _Pragma("unroll") for (int rep = 0; rep < RP(2); ++rep) { if (rep) GRID_BAR();
        if (PH(2)) { LB_PTRS(); ProbIn p; p.S.init(NTILE, LDU / 256, G, (int)blockIdx.x); p.H = H; p.W = (const bf16_t*)(ws + WS_WINT) + (size_t)l * LDU * 1024; p.U = U;
          pg8::gemm_phase(lds, p, wv); } }
        GRID_BAR();
        if (RP(3) > 1) { phase_post<true>(fresh_args(), lds, l, G, wv); GRID_BAR(); }
        if (PH(3)) phase_post(fresh_args(), lds, l, G, wv);
        GRID_BAR();
        _Pragma("unroll") for (int rep = 0; rep < RP(4); ++rep) { if (rep) GRID_BAR();
        if (PH(4)) { LB_PTRS(); AttnCtx A; A.U = U; A.AO = H; A.relb = a->relb + (size_t)l * 4 * 465; A.subln = a->subln + l * 64; A.lam = ((const float*)(ws + WS_LAM))[l]; A.lam_init = 0.8f - 0.6f * __expf(-0.3f * (float)l);
          attn_phase(A, lds, ctl + CW_QHEAD + (l + 2 * rep) * 4 * 8 * 64, l == 0 ? 33 : 32, bar.x, wv); } }
        GRID_BAR();
        _Pragma("unroll") for (int rep = 0; rep < (l == 0 ? RP(5) : 1); ++rep) { if (rep) GRID_BAR();
        if (PH(5)) { LB_PTRS(); ProbOut p; p.latent_only = l == 1; p.S.init(l == 0 ? NTILE : 128, 4, G, (int)blockIdx.x); p.AO = H; p.W = (const bf16_t*)(ws + WS_WOUTT) + (size_t)l * 1024 * 1024;
          p.XLin = l == 0 ? a->x : nullptr; p.XCin = l == 0 ? a->ctx : nullptr; p.X1 = (bf16_t*)(ws + WS_X1); p.mod = MODb + (size_t)l * 5 * 6144;
          pg8::gemm_phase(lds, p, wv); } }
        GRID_BAR();
        if (RP(6) > 1) { phase_route<true>(fresh_args(), lds, l, G, wv); GRID_BAR(); }
        if (PH(6)) phase_route(fresh_args(), lds, l, G, wv);
        GRID_BAR();
        const int nrt = moe_tables(fresh_args(), lds, l, wv);
        MoeSched ms; ms.G = G; ms.c = (int)blockIdx.x; ms.nrt = nrt; ms.nsh = l == 0 ? NTILE : 128; ms.latent_only = l == 1;
        ms.t2e = (const LAS int*)(lds + MISC_T2E); ms.tb = (const LAS int*)(lds + MISC_TB); ms.cn = ms.tb + 32;
        _Pragma("unroll") for (int rep = 0; rep < RP(7); ++rep) { if (rep) GRID_BAR();
        if (PH(7)) { LB_PTRS(); ProbGU p; p.S = ms; p.S.ncol = 2; p.H = H; p.W = (const bf16_t*)(ws + WS_WGU) + (size_t)l * 17 * 512 * 1024; p.list = (const unsigned*)(ws + WS_LIST); p.ACT = ACT;
          pg8::gemm_phase(lds, p, wv); } }
        GRID_BAR();
        _Pragma("unroll") for (int rep = 0; rep < RP(8); ++rep) { if (rep) GRID_BAR();
        if (PH(8)) { LB_PTRS(); ProbDN p; p.S = ms; p.S.ncol = 4; p.ACT = ACT; p.W = (const bf16_t*)(ws + WS_WDN) + (size_t)l * 17 * 1024 * 256; p.wl = (const float*)(ws + WS_WL); p.Y = U;
          pg8::gemm_phase(lds, p, wv); } }
        GRID_BAR();
        if (RP(9) > 1) { phase_combine<true>(fresh_args(), lds, l, G, wv); GRID_BAR(); }
        if (PH(9)) phase_combine(fresh_args(), lds, l, G, wv);
        if (l == 0) GRID_BAR();
    }
__global__ void __launch_bounds__(512, 2) fwd_kernel(Args a_unused) {
    KA a = fresh_args();
    extern __shared__ __attribute__((aligned(16))) unsigned char lds_raw[];
    LAS unsigned char* lds = (LAS unsigned char*)lds_raw;
    const int tid = threadIdx.x, G = gridDim.x, wv = __builtin_amdgcn_readfirstlane(tid >> 6);
    unsigned char* ws = a->ws;
    unsigned* ctl = (unsigned*)(ws + WS_CTL);
    for (int u = tid; u < (LDS_BYTES - MISC_OFF) / 4; u += 512) ((LAS unsigned*)(lds + MISC_OFF))[u] = 0u;
    __syncthreads();
    XcdBarrier bar = xcd_barrier_post(ctl + CW_BAR, (volatile LAS unsigned*)(lds + MISC_BARW), wv);
    bf16_t* H = (bf16_t*)(ws + WS_H); bf16_t* U = (bf16_t*)(ws + WS_U); bf16_t* ACT = (bf16_t*)(ws + WS_ACT);
    float* XC = (float*)(ws + WS_XC);
    const float* MODb = (const float*)(ws + WS_MOD);
    _Pragma("unroll") for (int rep = 0; rep < RP(0); ++rep) { if (PH(0)) prologue(fresh_args(), lds, G, wv);
    GRID_BAR(); }
    _Pragma("unroll") for (int rep = 0; rep < RP(1); ++rep) { if (PH(1)) phase_norm1(fresh_args(), G, wv);
    GRID_BAR(); }
    layer_body<0>(a, lds, G, bar, wv);
    layer_body<1>(a, lds, G, bar, wv);
}
#undef LB_PTRS

extern "C" void kernel_launch(void* const* d_in, const int* in_sizes, int n_in, void* d_out, int out_size, void* d_ws, size_t ws_size, hipStream_t stream) {
    static int grid = 0;
    if (grid == 0) {
        if (n_in != 31 || in_sizes[0] != NBATCH * SEQ * DM || out_size != NBATCH * SEQ * DM || ws_size < WS_END) {
            fprintf(stderr, "kernel_launch: unexpected shapes (n_in %d, in0 %d, out %d, ws %zu); nothing launched\n", n_in, n_in > 0 ? in_sizes[0] : -1, out_size, ws_size); grid = -1; return; }
        int dev = 0, cus = 0;
        if (hipGetDevice(&dev) != hipSuccess || hipDeviceGetAttribute(&cus, hipDeviceAttributeMultiprocessorCount, dev) != hipSuccess) { grid = -1; return; }
        if (hipFuncSetAttribute((const void*)fwd_kernel, hipFuncAttributeMaxDynamicSharedMemorySize, LDS_BYTES) != hipSuccess) { fprintf(stderr, "kernel_launch: hipFuncSetAttribute failed\n"); grid = -1; return; }
        int per_cu = 0;
        if (hipOccupancyMaxActiveBlocksPerMultiprocessor(&per_cu, (const void*)fwd_kernel, 512, LDS_BYTES) != hipSuccess || per_cu < 1) { fprintf(stderr, "kernel_launch: occupancy query says %d\n", per_cu); }
        (void)hipGetLastError();
        grid = cus;
    }
    if (grid < 0) return;
    if (hipMemsetAsync((char*)d_ws + WS_CTL, 0, CTL_ZERO_BYTES, stream) != hipSuccess) return;
    Args a{};
    const float* const* in = (const float* const*)d_in;
    a.x = in[0]; a.c = in[1]; a.ctx = in[2]; a.c_ctx = in[3]; a.w_mod = in[4]; a.b_mod = in[5]; a.norm_mix = in[6]; a.norm_ffn = in[7]; a.w_in = in[8]; a.w_out = in[9];
    a.gqa_qn = in[10]; a.gqa_kn = in[11]; a.relb = in[12]; a.lq1 = in[13]; a.lk1 = in[14]; a.lq2 = in[15]; a.lk2 = in[16]; a.subln = in[17];
    a.mla_qn = in[18]; a.mla_wqu = in[19]; a.mla_kvn = in[20]; a.mla_wkvu = in[21]; a.router_w = in[22]; a.router_b = in[23];
    a.wg = in[24]; a.wu = in[25]; a.wd = in[26]; a.sg = in[27]; a.su = in[28]; a.sd = in[29]; a.final_norm = in[30];
    a.out = (float*)d_out; a.ws = (unsigned char*)d_ws;
    hipLaunchKernelGGL(fwd_kernel, dim3(grid), dim3(512), LDS_BYTES, stream, a);
}
```
